# Optimizing an MI355X kernel written in HIP

```python
import jax, jax.numpy as jnp
from jax import lax
import numpy as np

D_MODEL = 4096
BATCH = 4
SEQ = 2048
DEPTH = 1

MIX_WIDTH = D_MODEL
ATTN_HEAD_DIM = 128
ATTN_WIDTH = MIX_WIDTH // 2
ATTN_HEADS = ATTN_WIDTH // ATTN_HEAD_DIM
DILATED_BRANCHES = ((128, 1), (512, 4), (2048, 16))
ATTN_BLOCK = 128
ROPE_THETA = 10000.0
SSD_WIDTH = MIX_WIDTH - ATTN_WIDTH
SSD_HEAD_DIM = 64
SSD_HEADS = SSD_WIDTH // SSD_HEAD_DIM
SSD_GROUPS = 8
SSD_STATE = 128
SSD_CONV = 4
SSD_CHUNK = 256
SSD_CONV_DIM = SSD_WIDTH + 2 * SSD_GROUPS * SSD_STATE
IN_PROJ_WIDTH = 3 * ATTN_WIDTH + SSD_WIDTH + SSD_CONV_DIM + SSD_HEADS
IN_SPLITS = (ATTN_WIDTH, 2 * ATTN_WIDTH, 3 * ATTN_WIDTH,
             3 * ATTN_WIDTH + SSD_WIDTH, 3 * ATTN_WIDTH + SSD_WIDTH + SSD_CONV_DIM)
N_EXPERT_GROUPS = 4
EXPERTS_PER_GROUP = 8
N_EXPERTS = N_EXPERT_GROUPS * EXPERTS_PER_GROUP
TOP_K = 2
EXPERT_FF = D_MODEL // 4
MOE_BLOCK = 128
NORM_EPS = 1e-6
SSD_NORM_EPS = 1e-5

kernel_name = 'hymba_dilated_ssd_hmoe_block'


def rms_norm(x, w, eps):
    xf = x.astype(jnp.float32)
    y = xf * lax.rsqrt(jnp.mean(xf * xf, axis=-1, keepdims=True) + eps)
    return (y * w.astype(jnp.float32)).astype(x.dtype)


def rotary(t, positions):
    half = t.shape[-1] // 2
    inv_freq = jnp.power(jnp.float32(ROPE_THETA), -jnp.arange(half, dtype=jnp.float32) / half)
    ang = positions.astype(jnp.float32)[..., None] * inv_freq
    cos = jnp.cos(ang)[:, :, None, :]
    sin = jnp.sin(ang)[:, :, None, :]
    tf = t.astype(jnp.float32)
    t1, t2 = tf[..., :half], tf[..., half:]
    return jnp.concatenate([t1 * cos - t2 * sin, t2 * cos + t1 * sin], axis=-1).astype(t.dtype)


def dilated_branch(q, k, v, n_back, dil):
    b, s, h, dh = q.shape
    L = s // dil
    nb = -(-L // ATTN_BLOCK)
    lp = nb * ATTN_BLOCK

    def to_sub(t):
        t = t.reshape(b, L, dil, h, dh).transpose(0, 2, 3, 1, 4)
        t = jnp.pad(t, ((0, 0), (0, 0), (0, 0), (0, lp - L), (0, 0)))
        return t.reshape(b, dil, h, nb, ATTN_BLOCK, dh)

    def with_prev(t):
        prev = jnp.pad(t, ((0, 0), (0, 0), (0, 0), (1, 0), (0, 0), (0, 0)))[:, :, :, :-1]
        return jnp.concatenate([prev, t], axis=4)

    qs = to_sub(q)
    kk = with_prev(to_sub(k))
    vv = with_prev(to_sub(v))
    scale = jnp.float32(dh ** -0.5)
    sc = jnp.einsum('brhnqc,brhnkc->brhnqk', qs, kk).astype(jnp.float32) * scale
    qi = jnp.arange(ATTN_BLOCK)[:, None]
    kj = jnp.arange(2 * ATTN_BLOCK)[None, :]
    dist = ATTN_BLOCK + qi - kj
    kpos = (jnp.arange(nb)[:, None, None] - 1) * ATTN_BLOCK + kj[None]
    mask = (dist >= 0)[None] & (dist <= n_back)[None] & (kpos >= 0)
    sc = jnp.where(mask, sc, -jnp.inf)
    m = jnp.max(sc, axis=-1)
    p = jnp.exp(sc - m[..., None])
    l = jnp.sum(p, axis=-1)
    o = jnp.einsum('brhnqk,brhnkc->brhnqc', p, vv.astype(jnp.float32)) / l[..., None]
    o = o.reshape(b, dil, h, lp, dh)[:, :, :, :L].transpose(0, 3, 1, 2, 4).reshape(b, s, h, dh)
    back = lambda t: t.reshape(b, dil, h, lp)[..., :L].transpose(0, 3, 1, 2).reshape(b, s, h)
    return o, back(m), back(l)


def dilated_attention(q, k, v):
    outs, ms, ls = [], [], []
    for window, dil in DILATED_BRANCHES:
        o, m, l = dilated_branch(q, k, v, window // dil, dil)
        outs.append(o); ms.append(m); ls.append(l)
    m_all = jnp.stack(ms)
    wts = jnp.stack(ls) * jnp.exp(m_all - jnp.max(m_all, axis=0, keepdims=True))
    o = jnp.sum(wts[..., None] * jnp.stack(outs), axis=0) / jnp.sum(wts, axis=0)[..., None]
    return o.astype(q.dtype)


def causal_depthwise_conv(x, w, bias):
    c = x.shape[-1]
    y = lax.conv_general_dilated(x, w[:, None, :].astype(x.dtype), window_strides=(1,),
                                 padding=[(SSD_CONV - 1, 0)],
                                 dimension_numbers=('NWC', 'WIO', 'NWC'),
                                 feature_group_count=c)
    return y + bias.astype(x.dtype)


def ssd_chunked(x, dA, Bm, Cm):
    b, s, h, p = x.shape
    g, n = Bm.shape[2], Bm.shape[3]
    r = h // g
    nc = -(-s // SSD_CHUNK)
    sp = nc * SSD_CHUNK
    padseq = lambda t: jnp.pad(t, [(0, 0), (0, sp - s)] + [(0, 0)] * (t.ndim - 2))
    xc = padseq(x).reshape(b, nc, SSD_CHUNK, g, r, p)
    bc = padseq(Bm).reshape(b, nc, SSD_CHUNK, g, n)
    cc = padseq(Cm).reshape(b, nc, SSD_CHUNK, g, n)
    ac = padseq(dA).reshape(b, nc, SSD_CHUNK, g, r).transpose(0, 3, 4, 1, 2)
    cs = jnp.cumsum(ac, axis=-1)
    idx = jnp.arange(SSD_CHUNK)
    causal = idx[:, None] >= idx[None, :]
    seg = jnp.exp(jnp.where(causal, cs[..., :, None] - cs[..., None, :], -jnp.inf))
    cb = jnp.einsum('bclgn,bcsgn->bcgls', cc, bc)
    y_diag = jnp.einsum('bcgls,bgrcls,bcsgrp->bclgrp', cb, seg, xc)
    decay_states = jnp.exp(cs[..., -1:] - cs)
    states = jnp.einsum('bclgn,bgrcl,bclgrp->cbgrpn', bc, decay_states, xc)
    chunk_decay = jnp.exp(cs[..., -1]).transpose(3, 0, 1, 2)

    def step(h_prev, inp):
        dec, st = inp
        return dec[..., None, None] * h_prev + st, h_prev

    h0 = jnp.zeros((b, g, r, p, n), jnp.float32)
    _, prev = lax.scan(step, h0, (chunk_decay, states))
    y_off = jnp.einsum('bclgn,cbgrpn,bgrcl->bclgrp', cc, prev, jnp.exp(cs))
    return (y_diag + y_off).reshape(b, sp, h, p)[:, :s]


def ssd_mixer(z, xbc_raw, dt_raw, conv_w, conv_b, dt_bias, a_log, d_skip, norm_w):
    b, s, _ = z.shape
    xbc = jax.nn.silu(causal_depthwise_conv(xbc_raw, conv_w, conv_b))
    xs, bm, cm = jnp.split(xbc, [SSD_WIDTH, SSD_WIDTH + SSD_GROUPS * SSD_STATE], axis=-1)
    xs = xs.reshape(b, s, SSD_HEADS, SSD_HEAD_DIM).astype(jnp.float32)
    bm = bm.reshape(b, s, SSD_GROUPS, SSD_STATE).astype(jnp.float32)
    cm = cm.reshape(b, s, SSD_GROUPS, SSD_STATE).astype(jnp.float32)
    dt = jax.nn.softplus(dt_raw.astype(jnp.float32) + dt_bias.astype(jnp.float32))
    a = -jnp.exp(a_log.astype(jnp.float32))
    y = ssd_chunked(xs * dt[..., None], dt * a, bm, cm)
    y = y + d_skip.astype(jnp.float32)[:, None] * xs
    y = y.reshape(b, s, SSD_WIDTH) * jax.nn.silu(z.astype(jnp.float32))
    yg = y.reshape(b, s, SSD_GROUPS, SSD_WIDTH // SSD_GROUPS)
    yg = yg * lax.rsqrt(jnp.mean(yg * yg, axis=-1, keepdims=True) + SSD_NORM_EPS)
    y = yg.reshape(b, s, SSD_WIDTH) * norm_w.astype(jnp.float32)
    return y.astype(z.dtype)


def hierarchical_moe(h, router_group_w, router_group_b, router_expert_w, router_expert_b,
                     w_gate, w_up, w_down):
    t, d = h.shape
    hf = h.astype(jnp.float32)
    g_probs = jax.nn.softmax(hf @ router_group_w.astype(jnp.float32) + router_group_b.astype(jnp.float32), axis=-1)
    g_p, g_idx = lax.top_k(g_probs, 1)
    e_logits = (hf @ router_expert_w.astype(jnp.float32) + router_expert_b.astype(jnp.float32))
    e_logits = e_logits.reshape(t, N_EXPERT_GROUPS, EXPERTS_PER_GROUP)
    e_sel = jnp.take_along_axis(e_logits, g_idx[:, :, None], axis=1)[:, 0]
    e_p, e_local = lax.top_k(jax.nn.softmax(e_sel, axis=-1), TOP_K)
    e_p = e_p / jnp.sum(e_p, axis=-1, keepdims=True)
    gates = g_p * e_p
    expert_ids = g_idx * EXPERTS_PER_GROUP + e_local

    n_assign = t * TOP_K
    flat_e = expert_ids.reshape(n_assign)
    flat_tok = jnp.repeat(jnp.arange(t, dtype=jnp.int32), TOP_K)
    flat_gate = gates.reshape(n_assign)
    order = jnp.argsort(flat_e, stable=True)
    e_sorted, tok_sorted, gate_sorted = flat_e[order], flat_tok[order], flat_gate[order]
    counts = jnp.bincount(flat_e, length=N_EXPERTS)
    starts = jnp.cumsum(counts) - counts
    padded = ((counts + MOE_BLOCK - 1) // MOE_BLOCK) * MOE_BLOCK
    pstarts = jnp.cumsum(padded) - padded
    dest = pstarts[e_sorted] + (jnp.arange(n_assign) - starts[e_sorted])
    n_blocks = n_assign // MOE_BLOCK + N_EXPERTS
    rows = n_blocks * MOE_BLOCK
    row_tok = jnp.full((rows,), t, jnp.int32).at[dest].set(tok_sorted)
    row_gate = jnp.zeros((rows,), jnp.float32).at[dest].set(gate_sorted)
    block_start = jnp.arange(n_blocks) * MOE_BLOCK
    block_e = jnp.minimum(jnp.sum(block_start[:, None] >= (pstarts + padded)[None, :], axis=1), N_EXPERTS - 1)
    h_pad = jnp.concatenate([h, jnp.zeros((1, d), h.dtype)], axis=0)
    xb = h_pad[row_tok].reshape(n_blocks, MOE_BLOCK, d)

    def expert_block(args):
        xblk, e = args
        return (jax.nn.silu(xblk @ w_gate[e]) * (xblk @ w_up[e])) @ w_down[e]

    yb = lax.map(expert_block, (xb, block_e))
    y_rows = yb.reshape(rows, d) * row_gate[:, None].astype(yb.dtype)
    return jax.ops.segment_sum(y_rows, row_tok, num_segments=t + 1)[:t]


def hybrid_layer(x, positions, norm_attn_w, w_in, q_norm_w, k_norm_w, conv_w, conv_b,
                 dt_bias, a_log, d_skip, ssd_norm_w, w_out, norm_ffn_w,
                 router_group_w, router_group_b, router_expert_w, router_expert_b,
                 w_gate, w_up, w_down):
    b, s, d = x.shape
    h = rms_norm(x, norm_attn_w, NORM_EPS)
    proj = jnp.einsum('bsd,de->bse', h, w_in)
    q, k, v, z, xbc, dt_raw = jnp.split(proj, IN_SPLITS, axis=-1)
    q = rotary(rms_norm(q.reshape(b, s, ATTN_HEADS, ATTN_HEAD_DIM), q_norm_w, NORM_EPS), positions)
    k = rotary(rms_norm(k.reshape(b, s, ATTN_HEADS, ATTN_HEAD_DIM), k_norm_w, NORM_EPS), positions)
    v = v.reshape(b, s, ATTN_HEADS, ATTN_HEAD_DIM)
    attn = dilated_attention(q, k, v).reshape(b, s, ATTN_WIDTH)
    ssd = ssd_mixer(z, xbc, dt_raw, conv_w, conv_b, dt_bias, a_log, d_skip, ssd_norm_w)
    mix = jnp.concatenate([attn, ssd], axis=-1)
    x = x + jnp.einsum('bse,ed->bsd', mix, w_out)
    h2 = rms_norm(x, norm_ffn_w, NORM_EPS).reshape(b * s, d)
    y = hierarchical_moe(h2, router_group_w, router_group_b, router_expert_w, router_expert_b,
                         w_gate, w_up, w_down)
    return x + y.reshape(b, s, d)


def setup_inputs(seed: int = 0) -> dict:
    key = jax.random.key(seed)
    ks = jax.random.split(key, 24)
    f32 = jnp.float32
    nrm = lambda k, shape, sc: jax.random.normal(k, shape, f32) * sc
    x = jax.random.normal(ks[0], (BATCH, SEQ, D_MODEL), f32)
    positions = jnp.tile(jnp.arange(SEQ, dtype=jnp.int32)[None, :], (BATCH, 1))
    dt0 = jnp.exp(jax.random.uniform(ks[8], (DEPTH, SSD_HEADS), f32, np.log(1e-3), np.log(1e-1)))
    return {
        'x': x,
        'positions': positions,
        'norm_attn_w': 1.0 + nrm(ks[1], (DEPTH, D_MODEL), 0.02),
        'w_in': nrm(ks[2], (DEPTH, D_MODEL, IN_PROJ_WIDTH), D_MODEL ** -0.5),
        'q_norm_w': 1.0 + nrm(ks[3], (DEPTH, ATTN_HEAD_DIM), 0.02),
        'k_norm_w': 1.0 + nrm(ks[4], (DEPTH, ATTN_HEAD_DIM), 0.02),
        'conv_w': nrm(ks[5], (DEPTH, SSD_CONV, SSD_CONV_DIM), SSD_CONV ** -0.5),
        'conv_b': nrm(ks[6], (DEPTH, SSD_CONV_DIM), 0.01),
        'dt_bias': dt0 + jnp.log(-jnp.expm1(-dt0)),
        'a_log': jnp.log(jax.random.uniform(ks[9], (DEPTH, SSD_HEADS), f32, 1.0, 16.0)),
        'd_skip': 1.0 + nrm(ks[10], (DEPTH, SSD_HEADS), 0.1),
        'ssd_norm_w': 1.0 + nrm(ks[11], (DEPTH, SSD_WIDTH), 0.02),
        'w_out': nrm(ks[12], (DEPTH, MIX_WIDTH, D_MODEL), MIX_WIDTH ** -0.5),
        'norm_ffn_w': 1.0 + nrm(ks[13], (DEPTH, D_MODEL), 0.02),
        'router_group_w': nrm(ks[14], (DEPTH, D_MODEL, N_EXPERT_GROUPS), D_MODEL ** -0.5),
        'router_group_b': nrm(ks[15], (DEPTH, N_EXPERT_GROUPS), 0.01),
        'router_expert_w': nrm(ks[16], (DEPTH, D_MODEL, N_EXPERTS), D_MODEL ** -0.5),
        'router_expert_b': nrm(ks[17], (DEPTH, N_EXPERTS), 0.01),
        'w_gate': nrm(ks[18], (DEPTH, N_EXPERTS, D_MODEL, EXPERT_FF), D_MODEL ** -0.5),
        'w_up': nrm(ks[19], (DEPTH, N_EXPERTS, D_MODEL, EXPERT_FF), D_MODEL ** -0.5),
        'w_down': nrm(ks[20], (DEPTH, N_EXPERTS, EXPERT_FF, D_MODEL), EXPERT_FF ** -0.5),
    }


def reference(x, positions, norm_attn_w, w_in, q_norm_w, k_norm_w, conv_w, conv_b,
              dt_bias, a_log, d_skip, ssd_norm_w, w_out, norm_ffn_w,
              router_group_w, router_group_b, router_expert_w, router_expert_b,
              w_gate, w_up, w_down):
    for layer in range(DEPTH):
        x = hybrid_layer(x, positions, norm_attn_w[layer], w_in[layer], q_norm_w[layer],
                         k_norm_w[layer], conv_w[layer], conv_b[layer], dt_bias[layer],
                         a_log[layer], d_skip[layer], ssd_norm_w[layer], w_out[layer],
                         norm_ffn_w[layer], router_group_w[layer], router_group_b[layer],
                         router_expert_w[layer], router_expert_b[layer],
                         w_gate[layer], w_up[layer], w_down[layer])
    return x
```

```cpp
#include <hip/hip_runtime.h>
#include <cstdio>
#include <cstdint>

#ifndef MK_ONE_LAUNCH
#define MK_ONE_LAUNCH 1
#endif

#define GAS __attribute__((address_space(1)))
#define LAS __attribute__((address_space(3)))
typedef unsigned short bf16;
typedef unsigned v4u __attribute__((ext_vector_type(4)));
typedef unsigned v2u __attribute__((ext_vector_type(2)));
typedef float f32x4 __attribute__((ext_vector_type(4)));
typedef float f32x2 __attribute__((ext_vector_type(2)));
typedef short bf16x8 __attribute__((ext_vector_type(8)));
#define LDS_WAIT() asm volatile("s_waitcnt lgkmcnt(0)" ::: "memory")
#define VM_WAIT() asm volatile("s_waitcnt vmcnt(0)" ::: "memory")

__device__ __forceinline__ float bflo(unsigned w) { return __uint_as_float(w << 16); }
__device__ __forceinline__ float bfhi(unsigned w) { return __uint_as_float(w & 0xffff0000u); }
__device__ __forceinline__ float bf2f(bf16 b) { return __uint_as_float(((unsigned)b) << 16); }
__device__ __forceinline__ unsigned f2bf(float f) { unsigned u = __float_as_uint(f); return (u + 0x7fffu + ((u >> 16) & 1u)) >> 16; }
__device__ __forceinline__ unsigned pk2(float lo, float hi) { return f2bf(lo) | (f2bf(hi) << 16); }
__device__ __forceinline__ float wave_sum(float v) {
#pragma unroll
    for (int o = 1; o < 64; o <<= 1) v += __shfl_xor(v, o);
    return v;
}
__device__ __forceinline__ float silu_f(float x) { return x / (1.0f + __expf(-x)); }

namespace pg8 {
#define PG8_LAS __attribute__((address_space(3)))
typedef unsigned short bf16_t;
typedef unsigned u32x4 __attribute__((ext_vector_type(4)));
constexpr int BM = 256, BK = 64, HALF = 128, HTB = HALF * BK * 2, STAGE_BYTES = 8 * HTB, NXCD = 8, WGM = 8;

__host__ __device__ __forceinline__ int lds_byte(int r, int c) { const int st = (r >> 4) * 2 + (c >> 5), rr = r & 15, cc = c & 31, ob = rr * 64 + cc * 2; return st * 1024 + (ob ^ (((ob >> 9) & 1) << 5)); }
__host__ __device__ __forceinline__ void stage_rc(int b, int& R, int& C) { const int st = b / 1024, sb = b % 1024, swz = sb ^ (((sb >> 9) & 1) << 5); R = (st >> 1) * 16 + swz / 64; C = (st & 1) * 32 + (swz % 64) / 2; }
__host__ __device__ __forceinline__ int perm32(int rho) { const int n = rho >> 4, i = rho & 15; return 8 * (i >> 2) + 4 * n + (i & 3); }

struct Unit { int pm, pn, pb; };
struct Gemm { const bf16_t* A; const bf16_t* Bt; int K; };

struct StaticOrder {
    int nM, nN, nwg, G, c;
    __device__ void init(int M, int N, int G_, int c_) { nM = M / BM; nN = N / BM; nwg = nM * nN; G = G_; c = c_; }
    __device__ bool next(int i, Unit& u) const {
        const long L = (long)i * G + c; if (L >= nwg) return false;
        int wgid = (int)L; { const int q = nwg / NXCD, r = nwg % NXCD, xcd = wgid % NXCD, off = wgid / NXCD; wgid = (xcd < r ? xcd * (q + 1) : r * (q + 1) + (xcd - r) * q) + off; }
        const int nig = WGM * nN, gid = wgid / nig, fm = gid * WGM, gsz = (nM - fm) < WGM ? (nM - fm) : WGM;
        u.pm = fm + ((wgid % nig) % gsz); u.pn = (wgid % nig) / gsz; u.pb = u.pn; return true;
    }
};
struct RangeOrder {
    StaticOrder S; int lo, hi;
    __device__ bool next(int i, Unit& u) const { return (lo + i < hi) && S.next(lo + i, u); }
};
struct MoeOrder {
    int MT, NT, G, c; const PG8_LAS int* pstart; int flat;
    __device__ bool next(int i, Unit& u) const {
        if (flat) { const long L = (long)i * G + c; if (L >= (long)MT * NT) return false; const int pn = (int)(L / MT), mt = (int)(L % MT);
            int e = 0; while (pstart[e + 1] <= mt * 256) ++e; u.pm = mt; u.pn = pn; u.pb = e * NT + pn; return true; }
        const int x = c & 7; int j = (c >> 3) + i * (G >> 3);
#pragma unroll
        for (int q = 0; q < 4; ++q) { const int e = x + 8 * q, t0 = pstart[e] >> 8, nm = (pstart[e + 1] >> 8) - t0, nu = nm * NT;
            if (j < nu) { const int pn = j / nm, mt = t0 + j % nm; u.pm = mt; u.pn = pn; u.pb = e * NT + pn; return true; }
            j -= nu; }
        return false;
    }
};

__device__ __forceinline__ unsigned cvt_pk_bf16(float lo, float hi) { unsigned r; asm volatile("v_cvt_pk_bf16_f32 %0, %1, %2" : "=v"(r) : "v"(lo), "v"(hi)); return r; }

struct EpiBf16 {
    static constexpr bool PERM = true;
    bf16_t* O; int ldc;
    __device__ __forceinline__ void operator()(const f32x4 (&acc)[2][2][4][2], const Unit& u, int wr, int wc, int fr, int fq) const {
        const int row0 = u.pm * BM + wr * 64 + fr, col0 = u.pn * BM + wc * 32 + 8 * fq;
#pragma unroll
        for (int ai = 0; ai < 2; ++ai)
#pragma unroll
            for (int m = 0; m < 4; ++m) { bf16_t* rowp = O + (size_t)(row0 + ai * HALF + m * 16) * ldc + col0;
#pragma unroll
                for (int bj = 0; bj < 2; ++bj) { const f32x4 v0 = acc[ai][bj][m][0], v1 = acc[ai][bj][m][1];
                    u32x4 w; w.x = cvt_pk_bf16(v0[0], v0[1]); w.y = cvt_pk_bf16(v0[2], v0[3]); w.z = cvt_pk_bf16(v1[0], v1[1]); w.w = cvt_pk_bf16(v1[2], v1[3]);
                    *(u32x4*)(rowp + bj * HALF) = w; } }
    }
};
struct EpiResid {
    static constexpr bool PERM = false;
    const float* base; float* out; int ldc;
    __device__ __forceinline__ void operator()(const f32x4 (&acc)[2][2][4][2], const Unit& u, int wr, int wc, int fr, int fq) const {
        const int row0 = u.pm * BM + wr * 64 + fr, col0 = u.pn * BM + wc * 32 + 4 * fq;
#pragma unroll
        for (int ai = 0; ai < 2; ++ai) {
            f32x4 b[4][2][2];
#pragma unroll
            for (int m = 0; m < 4; ++m) { const size_t off = (size_t)(row0 + ai * HALF + m * 16) * ldc + col0;
#pragma unroll
                for (int bj = 0; bj < 2; ++bj)
#pragma unroll
                    for (int n = 0; n < 2; ++n) b[m][bj][n] = *(const f32x4*)(base + off + bj * HALF + n * 16); }
#pragma unroll
            for (int m = 0; m < 4; ++m) { const size_t off = (size_t)(row0 + ai * HALF + m * 16) * ldc + col0;
#pragma unroll
                for (int bj = 0; bj < 2; ++bj)
#pragma unroll
                    for (int n = 0; n < 2; ++n) *(f32x4*)(out + off + bj * HALF + n * 16) = b[m][bj][n] + acc[ai][bj][m][n]; }
            asm volatile("" ::: "memory");
        }
    }
};
struct EpiResidBf16 {
    static constexpr bool PERM = true;
    const float* base; bf16_t* O; int ldc;
    __device__ __forceinline__ void operator()(const f32x4 (&acc)[2][2][4][2], const Unit& u, int wr, int wc, int fr, int fq) const {
        const int row0 = u.pm * BM + wr * 64 + fr, col0 = u.pn * BM + wc * 32 + 8 * fq;
#pragma unroll
        for (int ai = 0; ai < 2; ++ai) {
            f32x4 b[4][2][2];
#pragma unroll
            for (int m = 0; m < 4; ++m) { const size_t off = (size_t)(row0 + ai * HALF + m * 16) * ldc + col0;
#pragma unroll
                for (int bj = 0; bj < 2; ++bj)
#pragma unroll
                    for (int n = 0; n < 2; ++n) b[m][bj][n] = *(const f32x4*)(base + off + bj * HALF + n * 4); }
#pragma unroll
            for (int m = 0; m < 4; ++m) { const size_t off = (size_t)(row0 + ai * HALF + m * 16) * ldc + col0;
#pragma unroll
                for (int bj = 0; bj < 2; ++bj) { const f32x4 v0 = b[m][bj][0] + acc[ai][bj][m][0], v1 = b[m][bj][1] + acc[ai][bj][m][1];
                    u32x4 w; w.x = cvt_pk_bf16(v0[0], v0[1]); w.y = cvt_pk_bf16(v0[2], v0[3]); w.z = cvt_pk_bf16(v1[0], v1[1]); w.w = cvt_pk_bf16(v1[2], v1[3]);
                    *(u32x4*)(O + off + bj * HALF) = w; } }
            asm volatile("" ::: "memory");
        }
    }
};
struct EpiGateUp {
    static constexpr bool PERM = true;
    bf16_t* O; int ldc;
    __device__ __forceinline__ void operator()(const f32x4 (&acc)[2][2][4][2], const Unit& u, int wr, int wc, int fr, int fq) const {
        const int row0 = u.pm * BM + wr * 64 + fr, col0 = u.pn * HALF + wc * 32 + 8 * fq;
#pragma unroll
        for (int ai = 0; ai < 2; ++ai)
#pragma unroll
            for (int m = 0; m < 4; ++m) { bf16_t* rowp = O + (size_t)(row0 + ai * HALF + m * 16) * ldc + col0;
                float r[8];
#pragma unroll
                for (int n = 0; n < 2; ++n)
#pragma unroll
                    for (int j = 0; j < 4; ++j) { const float g = acc[ai][0][m][n][j], up = acc[ai][1][m][n][j]; r[n * 4 + j] = g * __builtin_amdgcn_rcpf(1.0f + __builtin_amdgcn_exp2f(-1.4426950408889634f * g)) * up; }
                u32x4 w; w.x = cvt_pk_bf16(r[0], r[1]); w.y = cvt_pk_bf16(r[2], r[3]); w.z = cvt_pk_bf16(r[4], r[5]); w.w = cvt_pk_bf16(r[6], r[7]);
                *(u32x4*)rowp = w; }
    }
};
struct EpiDown {
    static constexpr bool PERM = true;
    bf16_t* Y; int ldc; int T; const int* row_tok; const float* row_gate;
    __device__ __forceinline__ void operator()(const f32x4 (&acc)[2][2][4][2], const Unit& u, int wr, int wc, int fr, int fq) const {
        const int row0 = u.pm * BM + wr * 64 + fr, col0 = u.pn * BM + wc * 32 + 8 * fq;
#pragma unroll
        for (int ai = 0; ai < 2; ++ai)
#pragma unroll
            for (int m = 0; m < 4; ++m) { const int r = row0 + ai * HALF + m * 16; const int rt = row_tok[r]; const float gt = row_gate[r];
                if (rt >= 0) { bf16_t* rowp = Y + ((size_t)(rt & 1) * T + (size_t)(rt >> 1)) * ldc + col0;
#pragma unroll
                    for (int bj = 0; bj < 2; ++bj) { const f32x4 v0 = acc[ai][bj][m][0] * gt, v1 = acc[ai][bj][m][1] * gt;
                        u32x4 w; w.x = cvt_pk_bf16(v0[0], v0[1]); w.y = cvt_pk_bf16(v0[2], v0[3]); w.z = cvt_pk_bf16(v1[0], v1[1]); w.w = cvt_pk_bf16(v1[2], v1[3]);
                        *(u32x4*)(rowp + bj * HALF) = w; } } }
    }
};

template <class Epi, class Sched, bool ALIGN_EPI = true, bool GATHER = false>
__device__ __forceinline__ void gemm_phase(PG8_LAS unsigned char* lds, const Gemm g, const Sched& S, const Epi& E, const PG8_LAS unsigned* rowoff = nullptr) {
    const int tid = threadIdx.x, wid = __builtin_amdgcn_readfirstlane(tid >> 6), lane = tid & 63, wr = wid >> 2, wc = wid & 3, fr = lane & 15, fq = lane >> 4;
    const int K = g.K, nt = K / BK;
    unsigned voffA[2], voffB[2];
#pragma unroll
    for (int i = 0; i < 2; ++i) { int R, C; stage_rc(tid * 16 + i * 8192, R, C); const int Rb = Epi::PERM ? ((R & ~31) + perm32(R & 31)) : R;
        voffA[i] = (unsigned)(R * K + C) * 2u; voffB[i] = (unsigned)(Rb * K + C) * 2u; }
    const size_t kstep = (size_t)(BK * 2);
    int gR[2], gC[2];
#pragma unroll
    for (int i = 0; i < 2; ++i) { stage_rc(tid * 16 + i * 8192, gR[i], gC[i]); }
    unsigned c00 = 0, c01 = 0, c10 = 0, c11 = 0, n00 = 0, n01 = 0, n10 = 0, n11 = 0;
#define PG8_STAGE2(bufoff, gbase, o0, o1) do { \
        __builtin_amdgcn_global_load_lds((const unsigned*)((const char*)(gbase) + (o0)), (PG8_LAS unsigned*)(lds + (bufoff) + ldsw), 16, 0, 0); \
        __builtin_amdgcn_global_load_lds((const unsigned*)((const char*)(gbase) + (o1)), (PG8_LAS unsigned*)(lds + (bufoff) + ldsw + 8192), 16, 0, 0); } while (0)
#define PG8_GOFF(ui_, d00, d01, d10, d11) do { const PG8_LAS unsigned* r_ = rowoff + (ui_) * 256; d00 = r_[gR[0]] + gC[0] * 2; d01 = r_[gR[1]] + gC[1] * 2; d10 = r_[128 + gR[0]] + gC[0] * 2; d11 = r_[128 + gR[1]] + gC[1] * 2; } while (0)
    const size_t hstep = (size_t)HALF * K * 2;
    const size_t tstep = 2 * hstep;
    const unsigned ldsw = (unsigned)wid * 1024u;
    const int aoff = lds_byte(wr * 64 + fr, fq * 8), boff = lds_byte(wc * 32 + fr, fq * 8);
#define PG8_SA(b, h) (((b) * 2 + (h)) * HTB)
#define PG8_SB(b, h) ((4 + (b) * 2 + (h)) * HTB)
#define PG8_STAGE(bufoff, gbase, voff) do { _Pragma("unroll") for (int _i = 0; _i < 2; ++_i) \
        __builtin_amdgcn_global_load_lds((const unsigned*)((const char*)(gbase) + (voff)[_i]), (PG8_LAS unsigned*)(lds + (bufoff) + ldsw + _i * 8192), 16, 0, 0); } while (0)
#define PG8_LDA(dst, b, h) do { _Pragma("unroll") for (int m = 0; m < 4; ++m) _Pragma("unroll") for (int k = 0; k < 2; ++k) dst[m][k] = *(const PG8_LAS bf16x8*)(lds + PG8_SA(b, h) + aoff + m * 2048 + k * 1024); } while (0)
#define PG8_LDB(dst, b, h) do { _Pragma("unroll") for (int n = 0; n < 2; ++n) _Pragma("unroll") for (int k = 0; k < 2; ++k) dst[n][k] = *(const PG8_LAS bf16x8*)(lds + PG8_SB(b, h) + boff + n * 2048 + k * 1024); } while (0)
#define PG8_MMA(ai, bj, At, Bt) do { __builtin_amdgcn_s_setprio(1); _Pragma("unroll") for (int m = 0; m < 4; ++m) _Pragma("unroll") for (int n = 0; n < 2; ++n) _Pragma("unroll") for (int k = 0; k < 2; ++k) \
        acc[ai][bj][m][n] = __builtin_amdgcn_mfma_f32_16x16x32_bf16(Bt[n][k], At[m][k], acc[ai][bj][m][n], 0, 0, 0); __builtin_amdgcn_s_setprio(0); } while (0)
#define PG8_WAIT_V(n) asm volatile("s_waitcnt vmcnt(" #n ")" ::: "memory")
#define PG8_WAIT_L(n) asm volatile("s_waitcnt lgkmcnt(" #n ")" ::: "memory")
#define PG8_BAR __builtin_amdgcn_s_barrier()
#define PG8_SCHED __builtin_amdgcn_sched_barrier(0)
    Unit cur, nxt; int ui = 0;
    if (!S.next(0, cur)) return;
    f32x4 acc[2][2][4][2];
#pragma unroll
    for (int a = 0; a < 2; ++a)
#pragma unroll
        for (int b = 0; b < 2; ++b)
#pragma unroll
            for (int m = 0; m < 4; ++m)
#pragma unroll
                for (int n = 0; n < 2; ++n) acc[a][b][m][n] = (f32x4){0.f, 0.f, 0.f, 0.f};
    bf16x8 At[4][2], B0[2][2], B1[2][2];
    const char* cA = GATHER ? (const char*)g.A : (const char*)g.A + (size_t)cur.pm * tstep; const char* cB = (const char*)g.Bt + (size_t)cur.pb * tstep;
    if constexpr (GATHER) { PG8_GOFF(0, c00, c01, c10, c11); n00 = c00; n01 = c01; n10 = c10; n11 = c11; }
    PG8_STAGE(PG8_SB(0, 0), cB, voffB); PG8_STAGE(PG8_SB(0, 1), cB + hstep, voffB);
    if constexpr (GATHER) { PG8_STAGE2(PG8_SA(0, 0), cA, c00, c01); PG8_STAGE2(PG8_SA(0, 1), cA, c10, c11); } else { PG8_STAGE(PG8_SA(0, 0), cA, voffA); PG8_STAGE(PG8_SA(0, 1), cA + hstep, voffA); }
    if (wr == 1) PG8_BAR;
    PG8_WAIT_V(2); PG8_BAR;
    PG8_STAGE(PG8_SB(1, 0), cB + kstep, voffB); if constexpr (GATHER) PG8_STAGE2(PG8_SA(1, 0), cA + kstep, c00, c01); else PG8_STAGE(PG8_SA(1, 0), cA + kstep, voffA); PG8_STAGE(PG8_SB(1, 1), cB + hstep + kstep, voffB);
    PG8_WAIT_V(6); PG8_BAR;
    for (;;) {
        const bool has_next = S.next(ui + 1, nxt);
        const char* nA = GATHER ? (const char*)g.A : (has_next ? (const char*)g.A + (size_t)nxt.pm * tstep : cA); const char* nB = has_next ? (const char*)g.Bt + (size_t)nxt.pb * tstep : cB;
        if constexpr (GATHER) { if (has_next) PG8_GOFF(ui + 1, n00, n01, n10, n11); }
        for (int t = 0; t < nt; t += 2) {
            const bool last = (t == nt - 2);
            const char* a1 = cA + (size_t)(t + 1) * kstep;
            const char* a2 = last ? nA : cA + (size_t)(t + 2) * kstep; const char* b2 = last ? nB : cB + (size_t)(t + 2) * kstep;
            const char* a3 = a2 + kstep; const char* b3 = b2 + kstep;
            PG8_LDB(B0, 0, 0); PG8_LDB(B1, 0, 1); PG8_SCHED; PG8_LDA(At, 0, 0); if constexpr (GATHER) PG8_STAGE2(PG8_SA(1, 1), a1, c10, c11); else PG8_STAGE(PG8_SA(1, 1), a1 + hstep, voffA);
            PG8_WAIT_V(8); PG8_WAIT_L(0); PG8_BAR; PG8_MMA(0, 0, At, B0); PG8_MMA(0, 1, At, B1); PG8_BAR; PG8_SCHED;
            PG8_LDA(At, 0, 1); PG8_STAGE(PG8_SB(0, 0), b2, voffB); PG8_STAGE(PG8_SB(0, 1), b2 + hstep, voffB); if constexpr (GATHER) PG8_STAGE2(PG8_SA(0, 0), a2, last ? n00 : c00, last ? n01 : c01); else PG8_STAGE(PG8_SA(0, 0), a2, voffA);
            PG8_WAIT_V(8); PG8_WAIT_L(0); PG8_BAR; PG8_MMA(1, 0, At, B0); PG8_MMA(1, 1, At, B1); PG8_BAR; PG8_SCHED;
            PG8_LDB(B0, 1, 0); PG8_LDB(B1, 1, 1); PG8_SCHED; PG8_LDA(At, 1, 0); if constexpr (GATHER) PG8_STAGE2(PG8_SA(0, 1), a2, last ? n10 : c10, last ? n11 : c11); else PG8_STAGE(PG8_SA(0, 1), a2 + hstep, voffA);
            PG8_WAIT_V(8); PG8_WAIT_L(0); PG8_BAR; PG8_MMA(0, 0, At, B0); PG8_MMA(0, 1, At, B1); PG8_BAR; PG8_SCHED;
            PG8_LDA(At, 1, 1); PG8_STAGE(PG8_SB(1, 0), b3, voffB); PG8_STAGE(PG8_SB(1, 1), b3 + hstep, voffB); if constexpr (GATHER) PG8_STAGE2(PG8_SA(1, 0), a3, last ? n00 : c00, last ? n01 : c01); else PG8_STAGE(PG8_SA(1, 0), a3, voffA);
            PG8_WAIT_V(8); PG8_WAIT_L(0); PG8_BAR; PG8_MMA(1, 0, At, B0); PG8_MMA(1, 1, At, B1); PG8_BAR; PG8_SCHED;
        }
        if constexpr (ALIGN_EPI) { if (wr == 0) PG8_BAR; }
        E(acc, cur, wr, wc, fr, fq);
        if (!has_next) break;
#pragma unroll
        for (int a = 0; a < 2; ++a)
#pragma unroll
            for (int b = 0; b < 2; ++b)
#pragma unroll
                for (int m = 0; m < 4; ++m)
#pragma unroll
                    for (int n = 0; n < 2; ++n) acc[a][b][m][n] = (f32x4){0.f, 0.f, 0.f, 0.f};
        cur = nxt; cA = nA; cB = nB; ++ui; if constexpr (GATHER) { c00 = n00; c01 = n01; c10 = n10; c11 = n11; }
        if constexpr (ALIGN_EPI) { if (wr == 1) PG8_BAR; }
    }
    PG8_WAIT_V(0);
    if constexpr (!ALIGN_EPI) { if (wr == 0) PG8_BAR; }
    PG8_BAR;
#undef PG8_SA
#undef PG8_SB
#undef PG8_STAGE
#undef PG8_STAGE2
#undef PG8_GOFF
#undef PG8_LDA
#undef PG8_LDB
#undef PG8_MMA
#undef PG8_WAIT_V
#undef PG8_WAIT_L
#undef PG8_BAR
#undef PG8_SCHED
}
}
#define D_MODEL_ 4096
#define FF_ 1024
#define ECAP_ 8192

namespace pg2 {
using pg8::lds_byte; using pg8::stage_rc; using pg8::cvt_pk_bf16;
typedef short s16x4 __attribute__((ext_vector_type(4)));
constexpr int HTB = 16384, PB = 288, BBUF = 64 * PB, BOFF = 6 * HTB;
struct Unit2 { int pm, pn, e, half; };
struct Moe2Order {
    static constexpr bool DYNAMIC = false;
    int MT, NT, G, c; const LAS int* pstart; int flat; const LAS int* xe;
    __device__ bool next(int i, Unit2& u) const {
        if (flat) { const long L = (long)i * G + c; if (L >= (long)MT * NT) return false; const int pn = (int)(L / MT), mt = (int)(L % MT);
            int e = 0; while (pstart[e + 1] <= mt * 256) ++e; u.pm = mt; u.pn = pn; u.e = e; u.half = 0; return true; }
        const int x = c & 7; int j = (c >> 3) + i * (G >> 3);
#pragma unroll
        for (int q = 0; q < 4; ++q) { const int e = xe[x * 4 + q], t0 = pstart[e] >> 8, nm = (pstart[e + 1] >> 8) - t0, nu = nm * NT;
            if (j < nu) { u.pn = j / nm; u.pm = t0 + j % nm; u.e = e; u.half = 0; return true; }
            j -= nu; }
        return false;
    }
    __device__ __forceinline__ void wait_tile(int) const {}
};
struct Moe2OrderQ {
    static constexpr bool DYNAMIC = true;
    int MT, NT, c; const LAS int* pstart; int flat; const LAS int* xe; unsigned* tile_cnt; unsigned* tmo; unsigned* q; LAS int* slot;
    __device__ __forceinline__ bool decode(int j, Unit2& u) const {
        if (flat) { if (j >= MT * NT) return false; const int pn = j / MT, mt = j % MT;
            int e = 0; while (pstart[e + 1] <= mt * 256) ++e; u.pm = mt; u.pn = pn; u.e = e; u.half = 0; return true; }
        const int x = c & 7;
#pragma unroll
        for (int q_ = 0; q_ < 4; ++q_) { const int e = xe[x * 4 + q_], t0 = pstart[e] >> 8, nm = (pstart[e + 1] >> 8) - t0, nu = nm * NT;
            if (j < nu) { u.pn = j / nm; u.pm = t0 + j % nm; u.e = e; u.half = 0; return true; }
            j -= nu; }
        return false;
    }
    __device__ __forceinline__ unsigned grab() const { return __hip_atomic_fetch_add(q, 1u, __ATOMIC_RELAXED, __HIP_MEMORY_SCOPE_AGENT); }
    __device__ __forceinline__ void wait_tile(int pm) const {
        unsigned sp = 0;
        while ((unsigned)__builtin_amdgcn_readfirstlane(__hip_atomic_load(tile_cnt + 16 * pm, __ATOMIC_RELAXED, __HIP_MEMORY_SCOPE_AGENT)) < 64u) {
            __builtin_amdgcn_s_sleep(2);
            if (++sp > (1u << 22)) { if ((threadIdx.x & 63) == 0) __hip_atomic_store(tmo, 1u, __ATOMIC_RELAXED, __HIP_MEMORY_SCOPE_AGENT); break; } }
        __builtin_amdgcn_fence(__ATOMIC_ACQUIRE, "agent");
        asm volatile("s_waitcnt vmcnt(0)" ::: "memory");
    }
};
struct DownB { const float* w; __device__ __forceinline__ const float* operator()(int e, int pn, int c4, int& ldb) const { ldb = D_MODEL_; return w + (size_t)e * FF_ * D_MODEL_ + 128 * pn + 4 * c4; } };
struct EpiDown2 {
    bf16* Y; int ldc; int T; const int* row_tok; const float* row_gate;
    __device__ __forceinline__ void operator()(const f32x4 (&acc)[4][4], const Unit2& u, int wr, int wc, int fr, int fq) const {
#pragma unroll
        for (int m = 0; m < 4; ++m) { const int r = u.pm * 256 + wr * 64 + m * 16 + fr; const int rt = row_tok[r]; const float gt = row_gate[r];
            if (rt >= 0) { bf16* rowp = Y + ((size_t)(rt & 1) * T + (size_t)(rt >> 1)) * ldc + u.pn * 128 + wc * 64 + 4 * fq;
#pragma unroll
                for (int n = 0; n < 4; ++n) { const f32x4 v = acc[m][n] * gt; *(v2u*)(rowp + 16 * n) = (v2u){cvt_pk_bf16(v[0], v[1]), cvt_pk_bf16(v[2], v[3])}; } } }
    }
};
#define PG2_TR(dst, a, off) asm volatile("ds_read_b64_tr_b16 %0, %1 offset:%2" : "=&v"(dst) : "v"(a), "i"(off) : "memory")
template <class Epi, class Sched, class BF, bool GATHER>
__device__ __forceinline__ void gemm2_phase(LAS unsigned char* lds, const bf16* A, int K, const Sched& S, const BF& bfn, const Epi& E, const LAS unsigned* rowoff) {
    const int tid = threadIdx.x, wid = __builtin_amdgcn_readfirstlane(tid >> 6), lane = tid & 63, wr = wid >> 1, wc = wid & 1, fr = lane & 15, fq = lane >> 4;
    const int nt = K / 64;
    int gR[2], gC[2];
#pragma unroll
    for (int i = 0; i < 2; ++i) stage_rc(tid * 16 + i * 8192, gR[i], gC[i]);
    const unsigned ldsw = (unsigned)wid * 1024u;
    const int aoff = (wr >> 1) * HTB + lds_byte((wr & 1) * 64 + fr, fq * 8);
    const int c4 = tid & 31, kr = tid >> 5;
    const int bwr = BOFF + (8 * ((kr >> 2) & 1) + 4 * (kr >> 3) + (kr & 3)) * PB + 8 * c4;
    const int brd = (int)(uintptr_t)lds + BOFF + (16 * (fq >> 1) + 4 * (fq & 1) + ((lane & 15) >> 2)) * PB + (64 * wc + 4 * (lane & 3)) * 2;
    Unit2 u, un;
    int jn = 0;
    if constexpr (Sched::DYNAMIC) {
        if (tid == 0) { const int j0 = (int)S.grab(), j1 = (int)S.grab(); S.slot[0] = j0; S.slot[1] = j1; }
        __syncthreads();
        const int j0 = S.slot[0]; jn = S.slot[1];
        __syncthreads();
        if (!S.decode(j0, u)) return;
    } else { if (!S.next(0, u)) return; }
    unsigned o00, o01, o10, o11, p00, p01, p10, p11;
    const char* cA; const char* nA; const float* bp; const float* nbp; int ldb;
#define PG2_SETUP(U, UI, cA_, q00, q01, q10, q11, bp_) do { \
        if constexpr (GATHER) { const LAS unsigned* r_ = rowoff + (UI) * 256; cA_ = (const char*)A; \
            q00 = r_[gR[0]] + gC[0] * 2; q01 = r_[gR[1]] + gC[1] * 2; q10 = r_[128 + gR[0]] + gC[0] * 2; q11 = r_[128 + gR[1]] + gC[1] * 2; } \
        else { cA_ = (const char*)A + (size_t)(U).pm * 256 * K * 2; q00 = (unsigned)(gR[0] * K + gC[0]) * 2u; q01 = (unsigned)(gR[1] * K + gC[1]) * 2u; q10 = q00 + (unsigned)(128 * K * 2); q11 = q01 + (unsigned)(128 * K * 2); } \
        bp_ = bfn((U).e, (U).pn, c4, ldb) + (size_t)kr * ldb; } while (0)
#define PG2_STAGE_AH(buf, tau, h) do { const bool nx_ = (tau) >= nt; const char* g_ = (nx_ ? nA + (size_t)((tau) - nt) * 128 : cA + (size_t)(tau) * 128); \
        const unsigned q0_ = (h) ? (nx_ ? p10 : o10) : (nx_ ? p00 : o00), q1_ = (h) ? (nx_ ? p11 : o11) : (nx_ ? p01 : o01); \
        __builtin_amdgcn_global_load_lds((const unsigned*)(g_ + q0_), (LAS unsigned*)(lds + ((buf) * 2 + (h)) * HTB + ldsw), 16, 0, 0); \
        __builtin_amdgcn_global_load_lds((const unsigned*)(g_ + q1_), (LAS unsigned*)(lds + ((buf) * 2 + (h)) * HTB + ldsw + 8192), 16, 0, 0); } while (0)
#define PG2_LOAD_BH(breg, tau, i0) do { const float* b_ = (tau) >= nt ? nbp + (size_t)(((tau) - nt) * 64) * ldb : bp + (size_t)((tau) * 64) * ldb; \
        _Pragma("unroll") for (int i = (i0); i < (i0) + 2; ++i) { const float* p_ = b_ + (size_t)(16 * i) * ldb; \
        asm volatile("global_load_dwordx4 %0, %1, off" : "=&v"(breg[i]) : "v"(p_) : "memory"); } } while (0)
#define PG2_WRITE_B(breg, buf) do { _Pragma("unroll") for (int i = 0; i < 4; ++i) *(LAS v2u*)(lds + bwr + (buf) * BBUF + (32 * (i >> 1) + 16 * (i & 1)) * PB) = (v2u){cvt_pk_bf16(breg[i].x, breg[i].y), cvt_pk_bf16(breg[i].z, breg[i].w)}; } while (0)
#define PG2_FR(ks, af, l0, h0, l1, h1, l2, h2, l3, h3) do { \
            _Pragma("unroll") for (int m = 0; m < 4; ++m) af[m] = *(const LAS bf16x8*)(lds + ab + m * 2048 + (ks) * 1024); \
            PG2_TR(l0, bb, (ks) * 32 * PB + 0); PG2_TR(h0, bb, (ks) * 32 * PB + 0 + 8 * PB); PG2_TR(l1, bb, (ks) * 32 * PB + 32); PG2_TR(h1, bb, (ks) * 32 * PB + 32 + 8 * PB); \
            PG2_TR(l2, bb, (ks) * 32 * PB + 64); PG2_TR(h2, bb, (ks) * 32 * PB + 64 + 8 * PB); PG2_TR(l3, bb, (ks) * 32 * PB + 96); PG2_TR(h3, bb, (ks) * 32 * PB + 96 + 8 * PB); } while (0)
#define PG2_MMH(af, m0, l0, h0, l1, h1, l2, h2, l3, h3) do { \
            const bf16x8 b0 = {l0[0], l0[1], l0[2], l0[3], h0[0], h0[1], h0[2], h0[3]}, b1 = {l1[0], l1[1], l1[2], l1[3], h1[0], h1[1], h1[2], h1[3]}, \
                         b2 = {l2[0], l2[1], l2[2], l2[3], h2[0], h2[1], h2[2], h2[3]}, b3 = {l3[0], l3[1], l3[2], l3[3], h3[0], h3[1], h3[2], h3[3]}; \
            __builtin_amdgcn_s_setprio(1); \
            _Pragma("unroll") for (int m = (m0); m < (m0) + 2; ++m) { acc[m][0] = __builtin_amdgcn_mfma_f32_16x16x32_bf16(b0, af[m], acc[m][0], 0, 0, 0); acc[m][1] = __builtin_amdgcn_mfma_f32_16x16x32_bf16(b1, af[m], acc[m][1], 0, 0, 0); \
                acc[m][2] = __builtin_amdgcn_mfma_f32_16x16x32_bf16(b2, af[m], acc[m][2], 0, 0, 0); acc[m][3] = __builtin_amdgcn_mfma_f32_16x16x32_bf16(b3, af[m], acc[m][3], 0, 0, 0); } \
            __builtin_amdgcn_s_setprio(0); __builtin_amdgcn_sched_barrier(0); } while (0)
#define PG2_ITER(t_, b_, brn, brw) do { \
            const int ab = aoff + a0 * (2 * HTB), bb = brd + (b_) * BBUF; \
            const bool n1_ = ((t_) + 1 < nt) || has_next, n2_ = ((t_) + 2 < nt) || has_next; \
            bf16x8 afa[4], afb[4]; s16x4 al0, ah0, al1, ah1, al2, ah2, al3, ah3, bl0, bh0, bl1, bh1, bl2, bh2, bl3, bh3; \
            PG2_FR(0, afa, al0, ah0, al1, ah1, al2, ah2, al3, ah3); \
            if (n2_) PG2_STAGE_AH(a2, (t_) + 2, 0); \
            asm volatile("s_waitcnt lgkmcnt(0)" ::: "memory"); __builtin_amdgcn_sched_barrier(0); \
            PG2_FR(1, afb, bl0, bh0, bl1, bh1, bl2, bh2, bl3, bh3); \
            PG2_MMH(afa, 0, al0, ah0, al1, ah1, al2, ah2, al3, ah3); \
            if (n2_) PG2_STAGE_AH(a2, (t_) + 2, 1); \
            __builtin_amdgcn_sched_barrier(0); \
            PG2_MMH(afa, 2, al0, ah0, al1, ah1, al2, ah2, al3, ah3); \
            if (n2_) PG2_LOAD_BH(brw, (t_) + 2, 0); \
            asm volatile("s_waitcnt lgkmcnt(0)" ::: "memory"); __builtin_amdgcn_sched_barrier(0); \
            PG2_MMH(afb, 0, bl0, bh0, bl1, bh1, bl2, bh2, bl3, bh3); \
            if (n2_) PG2_LOAD_BH(brw, (t_) + 2, 2); \
            __builtin_amdgcn_sched_barrier(0); \
            PG2_MMH(afb, 2, bl0, bh0, bl1, bh1, bl2, bh2, bl3, bh3); \
            if (n1_) { if (n2_) asm volatile("s_waitcnt vmcnt(8)" ::: "memory"); else asm volatile("s_waitcnt vmcnt(0)" ::: "memory");     \
                       PG2_WRITE_B(brn, (b_) ^ 1); } \
            asm volatile("s_waitcnt lgkmcnt(0)" ::: "memory"); \
            __builtin_amdgcn_s_barrier(); asm volatile("" ::: "memory");                     \
            { const int r_ = a0; a0 = a1; a1 = a2; a2 = r_; } } while (0)
    if (wid == 0) S.wait_tile(u.pm);
    __builtin_amdgcn_s_barrier(); asm volatile("" ::: "memory");
    PG2_SETUP(u, 0, cA, o00, o01, o10, o11, bp);
    nA = cA; nbp = bp; p00 = o00; p01 = o01; p10 = o10; p11 = o11;
    f32x4 br0[4], br1[4];
    int a0 = 0, a1 = 1, a2 = 2;
    { const bool has_next = false; (void)has_next;
      PG2_STAGE_AH(0, 0, 0); PG2_STAGE_AH(0, 0, 1); PG2_LOAD_BH(br0, 0, 0); PG2_LOAD_BH(br0, 0, 2);
      PG2_STAGE_AH(1, 1, 0); PG2_STAGE_AH(1, 1, 1); PG2_LOAD_BH(br1, 1, 0); PG2_LOAD_BH(br1, 1, 2);
      asm volatile("s_waitcnt vmcnt(8)" ::: "memory");
      PG2_WRITE_B(br0, 0);
      asm volatile("s_waitcnt lgkmcnt(0)" ::: "memory");
      __builtin_amdgcn_s_barrier(); asm volatile("" ::: "memory"); }
#pragma unroll 1
    for (int ui = 0;; ++ui) {
        bool has_next;
        if constexpr (Sched::DYNAMIC) has_next = S.decode(jn, un); else has_next = S.next(ui + 1, un);
        if (has_next) PG2_SETUP(un, ui + 1, nA, p00, p01, p10, p11, nbp);
        if constexpr (Sched::DYNAMIC) {
            if (has_next && wid == 0) { unsigned vq = 0u; if (lane == 0) vq = S.grab();
                S.wait_tile(un.pm);
                if (lane == 0) S.slot[ui & 1] = (int)vq; }
        } else { if (has_next && wid == 0) S.wait_tile(un.pm); }
        f32x4 acc[4][4];
#pragma unroll
        for (int m = 0; m < 4; ++m)
#pragma unroll
            for (int n = 0; n < 4; ++n) acc[m][n] = (f32x4){0.f, 0.f, 0.f, 0.f};
#pragma unroll 1
        for (int t = 0; t < nt; t += 2) {
            PG2_ITER(t, 0, br1, br0);
            PG2_ITER(t + 1, 1, br0, br1);
        }
        E(acc, u, wr, wc, fr, fq);
        if (!has_next) break;
        u = un; cA = nA; bp = nbp; o00 = p00; o01 = p01; o10 = p10; o11 = p11;
        if constexpr (Sched::DYNAMIC) jn = S.slot[ui & 1];
    }
#undef PG2_SETUP
#undef PG2_STAGE_AH
#undef PG2_LOAD_BH
#undef PG2_WRITE_B
#undef PG2_FR
#undef PG2_MMH
#undef PG2_ITER
}
}

namespace pg3 {
using pg8::lds_byte; using pg8::stage_rc; using pg8::cvt_pk_bf16; using pg2::Unit2; using pg2::s16x4;
constexpr int HTB = 16384, PB = 544, BBUF = 64 * PB, BOFF = 4 * HTB;
struct GateUpB { const float* wg; const float* wu; __device__ __forceinline__ const float* operator()(int e, int pn, int c4, int& ldb) const { ldb = FF_; const int blk = c4 >> 2;
    const long long dlt = (const char*)wu - (const char*)wg;
    return (const float*)((const char*)wg + ((blk & 1) ? dlt : 0ll)) + (size_t)e * D_MODEL_ * FF_ + 128 * pn + 16 * (blk >> 1) + 4 * (c4 & 3); } };
struct EpiGateUp3 {
    bf16* O; int ldc; unsigned* tile_cnt;
    __device__ __forceinline__ void operator()(const f32x4 (&acc)[4][8], const Unit2& u, int wr, int wc, int fr, int fq) const {
#pragma unroll
        for (int m = 0; m < 4; ++m) { bf16* rowp = O + (size_t)(u.pm * 256 + wr * 64 + m * 16 + fr) * ldc + u.pn * 128 + 64 * wc + 4 * fq;
#pragma unroll
            for (int j = 0; j < 4; ++j) { float r[4];
#pragma unroll
                for (int i = 0; i < 4; ++i) { const float g = acc[m][2 * j][i], up = acc[m][2 * j + 1][i]; r[i] = g * __builtin_amdgcn_rcpf(1.0f + __builtin_amdgcn_exp2f(-1.4426950408889634f * g)) * up; }
                const unsigned long long pk = (unsigned long long)cvt_pk_bf16(r[0], r[1]) | ((unsigned long long)cvt_pk_bf16(r[2], r[3]) << 32);
                __hip_atomic_store((unsigned long long*)(rowp + 16 * j), pk, __ATOMIC_RELAXED, __HIP_MEMORY_SCOPE_AGENT); } }
    }
    static constexpr bool DEFER = true;
    __device__ __forceinline__ void publish(int pm) const { if ((threadIdx.x & 63) == 0) __hip_atomic_fetch_add(tile_cnt + 16 * pm, 1u, __ATOMIC_RELAXED, __HIP_MEMORY_SCOPE_AGENT); }
};
struct DownB3 { const float* w; __device__ __forceinline__ const float* operator()(int e, int pn, int c4, int& ldb) const { ldb = D_MODEL_; return w + (size_t)e * FF_ * D_MODEL_ + 256 * pn + 4 * c4; } };
struct EpiDown3 {
    static constexpr bool DEFER = false; __device__ __forceinline__ void publish(int) const {}
    bf16* Y; int ldc; int T; const int* row_tok; const float* row_gate; const LAS int* pstart; const LAS int* lcnt;
    __device__ __forceinline__ void operator()(const f32x4 (&acc)[4][8], const Unit2& u, int wr, int wc, int fr, int fq) const {
        const int s0 = (u.pm - (pstart[u.e] >> 8)) * 256 + wr * 64 + fr, cnt = lcnt[u.e]; const size_t lb = (size_t)u.e * ECAP_;
#pragma unroll
        for (int m = 0; m < 4; ++m) { const int s_ = s0 + m * 16; const bool ok = s_ < cnt; const int rt0 = row_tok[lb + (ok ? s_ : 0)]; const float gt = row_gate[lb + (ok ? s_ : 0)]; const int rt = ok ? rt0 : -1;
            if (rt >= 0) { bf16* rowp = Y + ((size_t)(rt & 1) * T + (size_t)(rt >> 1)) * ldc + u.pn * 256 + wc * 128 + 4 * fq;
#pragma unroll
                for (int n = 0; n < 8; ++n) { const f32x4 v = acc[m][n] * gt; *(v2u*)(rowp + 16 * n) = (v2u){cvt_pk_bf16(v[0], v[1]), cvt_pk_bf16(v[2], v[3])}; } } }
    }
};
template <class Epi, class Sched, class BF, bool GATHER>
__device__ __forceinline__ void gemm3_phase(LAS unsigned char* lds, const bf16* A, int K, const Sched& S, const BF& bfn, const Epi& E, const LAS unsigned* rowoff) {
    const int tid = threadIdx.x, wid = __builtin_amdgcn_readfirstlane(tid >> 6), lane = tid & 63, wr = wid >> 1, wc = wid & 1, fr = lane & 15, fq = lane >> 4;
    const int nt = K / 64;
    int gR[2], gC[2];
#pragma unroll
    for (int i = 0; i < 2; ++i) stage_rc(tid * 16 + i * 8192, gR[i], gC[i]);
    const unsigned ldsw = (unsigned)wid * 1024u;
    const int aoff = (wr >> 1) * HTB + lds_byte((wr & 1) * 64 + fr, fq * 8);
    const int c4 = tid & 63, kr = tid >> 6;
    const int bwr = BOFF + (8 * (kr >> 2) + (kr & 3)) * PB + 8 * c4;
    const int brd = (int)(uintptr_t)lds + BOFF + (16 * (fq >> 1) + 4 * (fq & 1) + ((lane & 15) >> 2)) * PB + (128 * wc + 4 * (lane & 3)) * 2;
    int pend = -1;
    Unit2 u;
    int jc = 0, jn = 0;
    if constexpr (Sched::DYNAMIC) {
        if (tid == 0) { const int j0 = (int)S.grab(), j1 = (int)S.grab(); S.slot[0] = j0; S.slot[1] = j1; }
        __syncthreads();
        jc = __builtin_amdgcn_readfirstlane(S.slot[0]); jn = __builtin_amdgcn_readfirstlane(S.slot[1]);
        __syncthreads();
    }
#pragma unroll 1
    for (int ui = 0;; ++ui) {
        bool have;
        if constexpr (Sched::DYNAMIC) have = __builtin_amdgcn_readfirstlane((int)S.decode(jc, u)) != 0; else have = __builtin_amdgcn_readfirstlane((int)S.next(ui, u)) != 0;
        if (!have) break;
        u.pm = __builtin_amdgcn_readfirstlane(u.pm); u.pn = __builtin_amdgcn_readfirstlane(u.pn); u.e = __builtin_amdgcn_readfirstlane(u.e);
        if constexpr (Sched::DYNAMIC) {
            if (wid == 0) { unsigned vq = 0u; if (lane == 0) vq = S.grab();
                S.wait_tile(u.pm);
                if (lane == 0) S.slot[ui & 1] = (int)vq; }
            __builtin_amdgcn_s_barrier(); asm volatile("" ::: "memory"); }
        f32x4 acc[4][8];
#pragma unroll
        for (int m = 0; m < 4; ++m)
#pragma unroll
            for (int n = 0; n < 8; ++n) acc[m][n] = (f32x4){0.f, 0.f, 0.f, 0.f};
        const char* cA; unsigned o00, o01, o10, o11;
        if constexpr (GATHER) { const LAS unsigned* r_ = rowoff + ui * 256; cA = (const char*)A;
            o00 = r_[gR[0]] + gC[0] * 2; o01 = r_[gR[1]] + gC[1] * 2; o10 = r_[128 + gR[0]] + gC[0] * 2; o11 = r_[128 + gR[1]] + gC[1] * 2; }
        else { cA = (const char*)A + (size_t)u.pm * 256 * K * 2; o00 = (unsigned)(gR[0] * K + gC[0]) * 2u; o01 = (unsigned)(gR[1] * K + gC[1]) * 2u; o10 = o00 + (unsigned)(128 * K * 2); o11 = o01 + (unsigned)(128 * K * 2); }
        int ldb; const float* bp = bfn(u.e, u.pn, c4, ldb) + (size_t)kr * ldb;
#define PG3_STAGE_A(buf, kt) do { const char* g_ = cA + (size_t)(kt) * 128; \
        __builtin_amdgcn_global_load_lds((const unsigned*)(g_ + o00), (LAS unsigned*)(lds + ((buf) * 2 + 0) * HTB + ldsw), 16, 0, 0); \
        __builtin_amdgcn_global_load_lds((const unsigned*)(g_ + o01), (LAS unsigned*)(lds + ((buf) * 2 + 0) * HTB + ldsw + 8192), 16, 0, 0); \
        __builtin_amdgcn_global_load_lds((const unsigned*)(g_ + o10), (LAS unsigned*)(lds + ((buf) * 2 + 1) * HTB + ldsw), 16, 0, 0); \
        __builtin_amdgcn_global_load_lds((const unsigned*)(g_ + o11), (LAS unsigned*)(lds + ((buf) * 2 + 1) * HTB + ldsw + 8192), 16, 0, 0); } while (0)
#define PG3_LOAD_B(kt) do { _Pragma("unroll") for (int i = 0; i < 8; ++i) { const float* p_ = bp + (size_t)((kt) * 64 + 8 * i) * ldb; \
        asm volatile("global_load_dwordx4 %0, %1, off" : "=&v"(breg[i]) : "v"(p_) : "memory"); } } while (0)
#define PG3_WRITE_B(buf) do { _Pragma("unroll") for (int i = 0; i < 8; ++i) *(LAS v2u*)(lds + bwr + (buf) * BBUF + (32 * (i >> 2) + 16 * ((i >> 1) & 1) + 4 * (i & 1)) * PB) = (v2u){cvt_pk_bf16(breg[i].x, breg[i].y), cvt_pk_bf16(breg[i].z, breg[i].w)}; } while (0)
        f32x4 breg[8];
        PG3_LOAD_B(0); PG3_STAGE_A(0, 0);
        asm volatile("s_waitcnt vmcnt(0)" ::: "memory");
        if constexpr (Epi::DEFER) { if (pend >= 0) { E.publish(pend); pend = -1; } }
        PG3_WRITE_B(0);
        PG3_LOAD_B(1);
        asm volatile("s_waitcnt lgkmcnt(0)" ::: "memory"); __builtin_amdgcn_s_barrier(); asm volatile("" ::: "memory");
#define PG3_TRP(l_, h_, n_, ks_) PG2_TR(l_, bb, (ks_) * 32 * PB + (n_) * 32); PG2_TR(h_, bb, (ks_) * 32 * PB + (n_) * 32 + 8 * PB)
#define PG3_BF(l_, h_) ((bf16x8){l_[0], l_[1], l_[2], l_[3], h_[0], h_[1], h_[2], h_[3]})
#define PG3_KS(ks) do { bf16x8 af[4]; s16x4 l0, h0, l1, h1, l2, h2, l3, h3, l4, h4, l5, h5, l6, h6, l7, h7; \
            _Pragma("unroll") for (int m = 0; m < 4; ++m) af[m] = *(const LAS bf16x8*)(lds + ab + m * 2048 + (ks) * 1024); \
            PG3_TRP(l0, h0, 0, ks); PG3_TRP(l1, h1, 1, ks); PG3_TRP(l2, h2, 2, ks); PG3_TRP(l3, h3, 3, ks); PG3_TRP(l4, h4, 4, ks); PG3_TRP(l5, h5, 5, ks); PG3_TRP(l6, h6, 6, ks); PG3_TRP(l7, h7, 7, ks); \
            asm volatile("s_waitcnt lgkmcnt(0)" ::: "memory"); __builtin_amdgcn_sched_barrier(0); \
            const bf16x8 b0 = PG3_BF(l0, h0), b1 = PG3_BF(l1, h1), b2 = PG3_BF(l2, h2), b3 = PG3_BF(l3, h3), b4 = PG3_BF(l4, h4), b5 = PG3_BF(l5, h5), b6 = PG3_BF(l6, h6), b7 = PG3_BF(l7, h7); \
            __builtin_amdgcn_s_setprio(1); \
            _Pragma("unroll") for (int m = 0; m < 4; ++m) { \
                acc[m][0] = __builtin_amdgcn_mfma_f32_16x16x32_bf16(b0, af[m], acc[m][0], 0, 0, 0); acc[m][1] = __builtin_amdgcn_mfma_f32_16x16x32_bf16(b1, af[m], acc[m][1], 0, 0, 0); \
                acc[m][2] = __builtin_amdgcn_mfma_f32_16x16x32_bf16(b2, af[m], acc[m][2], 0, 0, 0); acc[m][3] = __builtin_amdgcn_mfma_f32_16x16x32_bf16(b3, af[m], acc[m][3], 0, 0, 0); \
                acc[m][4] = __builtin_amdgcn_mfma_f32_16x16x32_bf16(b4, af[m], acc[m][4], 0, 0, 0); acc[m][5] = __builtin_amdgcn_mfma_f32_16x16x32_bf16(b5, af[m], acc[m][5], 0, 0, 0); \
                acc[m][6] = __builtin_amdgcn_mfma_f32_16x16x32_bf16(b6, af[m], acc[m][6], 0, 0, 0); acc[m][7] = __builtin_amdgcn_mfma_f32_16x16x32_bf16(b7, af[m], acc[m][7], 0, 0, 0); } \
            __builtin_amdgcn_s_setprio(0); } while (0)
#pragma unroll 1
        for (int t = 0; t < nt; ++t) {
            const int b = t & 1;
            if (t + 1 < nt) PG3_STAGE_A(b ^ 1, t + 1);
            const int ab = aoff + b * 2 * HTB, bb = brd + b * BBUF;
            PG3_KS(0);
            if (t + 1 < nt) {
                asm volatile("s_waitcnt vmcnt(4)" ::: "memory");
                PG3_WRITE_B(b ^ 1);
                if (t + 2 < nt) PG3_LOAD_B(t + 2);
            }
            PG3_KS(1);
            if (t + 1 < nt) { if (t + 2 < nt) asm volatile("s_waitcnt vmcnt(8)" ::: "memory"); else asm volatile("s_waitcnt vmcnt(0)" ::: "memory"); }
            asm volatile("s_waitcnt lgkmcnt(0)" ::: "memory"); __builtin_amdgcn_s_barrier(); asm volatile("" ::: "memory");
        }
        E(acc, u, wr, wc, fr, fq);
        if constexpr (Epi::DEFER) pend = u.pm;
        if constexpr (Sched::DYNAMIC) { jc = jn; jn = __builtin_amdgcn_readfirstlane(S.slot[ui & 1]); }
#undef PG3_STAGE_A
#undef PG3_LOAD_B
#undef PG3_WRITE_B
#undef PG3_TRP
#undef PG3_BF
#undef PG3_KS
    }
    if constexpr (Epi::DEFER) { if (pend >= 0) { asm volatile("s_waitcnt vmcnt(0)" ::: "memory"); E.publish(pend); } }
}
}

constexpr int NWAVES = 8;
constexpr int D = 4096, NB = 4, SEQ = 2048, T = NB * SEQ;
constexpr int AW = 2048, NH = 16, HD = 128;
constexpr int SW = 2048, SH = 32, SP = 64, SG = 8, SN = 128;
constexpr int NPROJ = 12288, NPROJ_ALL = 12320;
constexpr int Q0 = 0, K0 = 2048, V0 = 4096, Z0 = 6144, XBC0 = 8192;
constexpr int NE = 32, EPG = 8, NGRP = 4, FF = 1024;
constexpr int ECAP = T;
constexpr int MAXMT = 96;
constexpr float NORM_EPS = 1e-6f, SSD_NORM_EPS = 1e-5f;

constexpr size_t al256(size_t x) { return (x + 255) & ~(size_t)255; }
constexpr size_t WS_CTL = 0, CTL_ZERO_BYTES = 1u << 20;
constexpr size_t WS_WIN = CTL_ZERO_BYTES;
constexpr size_t WS_WOUT = WS_WIN + al256((size_t)NPROJ_ALL * D * 2);
constexpr size_t WS_WGU = WS_WOUT + (size_t)D * D * 2;
constexpr size_t WS_WD = WS_WGU + (size_t)NE * 2 * FF * D * 2;
constexpr size_t WS_H = WS_WD + (size_t)NE * D * FF * 2;
constexpr size_t WS_PROJ = WS_H + (size_t)T * D * 2;
constexpr size_t WS_QN = WS_PROJ + (size_t)T * NPROJ * 2;
constexpr size_t WS_KN = WS_QN + (size_t)T * AW * 2;
constexpr size_t WS_XC = WS_KN + (size_t)T * AW * 2;
constexpr size_t WS_DT = WS_XC + (size_t)T * 4096 * 2;
constexpr size_t WS_DA = WS_DT + (size_t)T * SH * 4;
constexpr size_t WS_YG = WS_DA + (size_t)T * SH * 4;
constexpr size_t WS_MIX = WS_YG + (size_t)T * SW * 4;
constexpr size_t WS_ACT = WS_MIX + (size_t)T * D * 2;
constexpr size_t WS_YS = WS_ACT + (size_t)MAXMT * 256 * FF * 2;
constexpr size_t WS_TOK = WS_YS + (size_t)2 * T * D * 2;
constexpr size_t WS_ROW = WS_TOK + (size_t)3 * T * 2 * 4;
constexpr size_t WS_OBR = WS_ROW + (size_t)2 * MAXMT * 256 * 4;
constexpr size_t WS_ML = WS_OBR + (size_t)3 * T * AW * 2;
constexpr size_t WS_ST = WS_ML + (size_t)3 * T * NH * 8;
constexpr size_t WS_CT = WS_ST + (size_t)NB * 8 * SH * SP * SN * 4;
constexpr size_t WS_RW = WS_CT + 4096;
constexpr size_t WS_END = WS_RW + (size_t)D * 48 * 4;
static_assert((size_t)MAXMT * 256 * D * 2 <= (size_t)T * NPROJ * 2, "Xg overlays PROJ");
constexpr int CW_CNT = 64;
constexpr int CW_BAR = 4096;
constexpr int CW_DQ = 12288;
constexpr int CW_TILE = 8192;

constexpr int RING_OFF = 0, RING_BYTES = 135168;
constexpr int LDSCTL_OFF = RING_BYTES;
constexpr int L_MISC = LDSCTL_OFF;
constexpr int L_TILE_E = LDSCTL_OFF + 256;
constexpr int L_PSTART = LDSCTL_OFF + 256 + 512;
constexpr int L_CNT = LDSCTL_OFF + 256 + 512 + 256;
constexpr int L_XE = LDSCTL_OFF + 1280;
constexpr int L_ATT = LDSCTL_OFF + 2048;
constexpr int L_SSD = LDSCTL_OFF + 4096;
constexpr int LDS_BYTES = 151552;
static_assert(L_CNT + 128 <= L_ATT && L_ATT + 2048 <= L_SSD && L_SSD + 8192 + 128 <= LDS_BYTES, "LDS map");

#define XB_TMO      128
#define XB_XCNT(j)  (256  + 64 * (j))
#define XB_XSUB(j)  (1280 + 64 * (j))
#define XB_XGEN(j)  (2304 + 64 * (j))
#define XB_TOP      3328
#define XB_TOPGEN   3392
#define XCD_BAR_WORDS 3456
#define XB_SPIN_CAP (1u << 20)
__device__ __forceinline__ unsigned xb_ld(unsigned* p)              { return __hip_atomic_load(p, __ATOMIC_RELAXED, __HIP_MEMORY_SCOPE_AGENT); }
__device__ __forceinline__ unsigned xb_add(unsigned* p, unsigned v) { return __hip_atomic_fetch_add(p, v, __ATOMIC_RELAXED, __HIP_MEMORY_SCOPE_AGENT); }
__device__ __forceinline__ unsigned xb_xcc_id() { return (unsigned)__builtin_amdgcn_s_getreg((3 << 11) | 20) & 0xFu; }
#define XB_SPIN(cond, bar) do { unsigned _sp = 0; while (cond) { __builtin_amdgcn_s_sleep(1); \
    if ((++_sp & 255u) == 0u) { if (xb_ld(&(bar)[XB_TMO])) break; if (_sp > XB_SPIN_CAP) { atomicAdd(&(bar)[XB_TMO], 1u); break; } } } } while (0)
struct XcdBarrier { unsigned* bar; unsigned x; volatile LAS unsigned* st; };
__device__ __forceinline__ XcdBarrier xcd_barrier_post(unsigned* bar, volatile LAS unsigned* st) {
    XcdBarrier b; b.bar = bar; b.x = xb_xcc_id(); b.st = st;
    if (threadIdx.x == 0) (void)xb_add(&bar[XB_XCNT(b.x)], 1u);
    return b;
}
__device__ __forceinline__ void xcd_barrier_complete(unsigned* bar, unsigned x, unsigned& nloc, unsigned& nx) {
    const unsigned G = gridDim.x * gridDim.y * gridDim.z;
    unsigned sum, cnt, mine, sp = 0u;
    for (;;) {
        sum = 0u; cnt = 0u; mine = 0u;
#pragma unroll
        for (unsigned j = 0; j < 16; ++j) { const unsigned c = xb_ld(&bar[XB_XCNT(j)]); sum += c; cnt += (c > 0u) ? 1u : 0u; mine = (j == x) ? c : mine; }
        if (sum == G) break;
        __builtin_amdgcn_s_sleep(1);
        if ((++sp & 255u) == 0u) { if (xb_ld(&bar[XB_TMO])) break; if (sp > XB_SPIN_CAP) { atomicAdd(&bar[XB_TMO], 1u); break; } }
    }
    nloc = mine > 0u ? mine : 1u; nx = cnt > 0u ? cnt : 1u;
}
__device__ __forceinline__ void xcd_barrier(const XcdBarrier& b) {
    asm volatile("s_waitcnt vmcnt(0)" ::: "memory");
    __syncthreads();
    if (threadIdx.x == 0) {
        unsigned* bar = b.bar;
        __builtin_amdgcn_s_waitcnt(0);
        unsigned nloc = b.st[0], nx = b.st[1];
        if (nloc == 0u) { xcd_barrier_complete(bar, b.x, nloc, nx); b.st[0] = nloc; b.st[1] = nx; }
        const unsigned old = xb_add(&bar[XB_XSUB(b.x)], 1u);
        const unsigned gen = old / nloc;
        if (old + 1u == (gen + 1u) * nloc) {
            __builtin_amdgcn_fence(__ATOMIC_RELEASE, "agent");
            asm volatile("s_waitcnt vmcnt(0)" ::: "memory");
            const unsigned og = xb_add(&bar[XB_TOP], 1u);
            const unsigned tg = og / nx;
            if (og + 1u == (tg + 1u) * nx) xb_add(&bar[XB_TOPGEN], 1u);
            else XB_SPIN(xb_ld(&bar[XB_TOPGEN]) == tg, bar);
            __builtin_amdgcn_fence(__ATOMIC_ACQUIRE, "agent");
            xb_add(&bar[XB_XGEN(b.x)], 1u);
            asm volatile("s_waitcnt vmcnt(0)" ::: "memory");
        } else {
            XB_SPIN(xb_ld(&bar[XB_XGEN(b.x)]) == gen, bar);
            __builtin_amdgcn_fence(__ATOMIC_ACQUIRE, "agent");
            asm volatile("s_waitcnt vmcnt(0)" ::: "memory");
        }
    }
    __syncthreads();
}

struct Args { const void* in[21]; float* out; unsigned char* ws; int ph_lo, ph_hi; };
struct Frame {
    LAS unsigned char* lds;
    unsigned* ctl;
    int tid, lane, wave, G, bx;
    const float *x; const int* pos; const float *norm_attn_w, *w_in, *q_norm_w, *k_norm_w, *conv_w, *conv_b, *dt_bias, *a_log, *d_skip, *ssd_norm_w, *w_out, *norm_ffn_w,
        *rg_w, *rg_b, *re_w, *re_b, *w_gate, *w_up, *w_down;
    float* out;
    bf16 *WinT, *WoT, *WguT, *WdT, *Hb, *PROJ, *QN, *KN, *XC, *MIX, *ACT, *YS, *XG;
    float *DT, *DA, *YG; bf16* OBR; float* ML; float *ST, *CT, *RW; bf16* X1B;
    int *tok_e, *tok_slot; float* tok_gate; int* row_tok; float* row_gate;
};

#define PIN_FRAME(F) Frame F = F0; asm volatile("" : "+v"(F.lane), "+v"(F.tid))
__device__ __forceinline__ void transpose_item(const float* W, int N, bf16* dst, int Kd, int k0, int n0, LAS float* scr, int lane) {
    const float* src = W + (size_t)(k0 + (lane >> 5)) * N + n0 + (lane & 31);
    float v[32];
#pragma unroll
    for (int i = 0; i < 32; ++i) v[i] = __builtin_nontemporal_load(src + (size_t)(2 * i) * N);
#pragma unroll
    for (int i = 0; i < 32; ++i) scr[(2 * i + (lane >> 5)) * 33 + (lane & 31)] = v[i];
    LDS_WAIT(); asm volatile("" ::: "memory");
    const int c = lane & 7;
#pragma unroll
    for (int j = 0; j < 4; ++j) { const int n = (lane >> 3) + 8 * j; const LAS float* s = scr + (8 * c) * 33 + n;
        v4u o; o.x = pk2(s[0 * 33], s[1 * 33]); o.y = pk2(s[2 * 33], s[3 * 33]); o.z = pk2(s[4 * 33], s[5 * 33]); o.w = pk2(s[6 * 33], s[7 * 33]);
        *(v4u*)(dst + (size_t)n * Kd + k0 + 8 * c) = o; }
    LDS_WAIT(); asm volatile("" ::: "memory");
}
__device__ __forceinline__ void rms_row_to_bf16(const float* xrow, const float* nw, bf16* orow, int lane) {
    const f32x4* xr = (const f32x4*)xrow + lane; const f32x4* wr = (const f32x4*)nw + lane;
    f32x4 v[16]; float s = 0.f;
#pragma unroll
    for (int j = 0; j < 16; ++j) { v[j] = xr[64 * j]; s += (v[j].x * v[j].x + v[j].y * v[j].y) + (v[j].z * v[j].z + v[j].w * v[j].w); }
    const float rstd = 1.0f / sqrtf(wave_sum(s) * (1.f / D) + NORM_EPS);
    unsigned long long* o8 = (unsigned long long*)orow + lane;
#pragma unroll
    for (int j = 0; j < 16; ++j) { const f32x4 w = wr[64 * j]; o8[64 * j] = (unsigned long long)pk2(v[j].x * rstd * w.x, v[j].y * rstd * w.y) | ((unsigned long long)pk2(v[j].z * rstd * w.z, v[j].w * rstd * w.w) << 32); }
}
struct TI { const float* src; bf16* dst; int N, Kd; };
__device__ __forceinline__ void t_issue(const TI& t, int lane, f32x4 (&v)[16]) {
    const f32x4* p = (const f32x4*)(t.src + (size_t)(lane >> 4) * t.N + 4 * (lane & 15));
#pragma unroll
    for (int i = 0; i < 16; ++i) v[i] = __builtin_nontemporal_load((const f32x4*)((const float*)p + (size_t)(4 * i) * t.N));
}
__device__ __forceinline__ void t_finish(const TI& t, int lane, const f32x4 (&v)[16], LAS float* scr) {
    const int c = lane & 7, kr = lane >> 4, c4 = lane & 15;
#pragma unroll
    for (int hf = 0; hf < 2; ++hf) {
        if ((c4 >> 3) == hf) {
#pragma unroll
            for (int i = 0; i < 16; ++i) { LAS float* q = scr + (4 * i + kr) * 33 + 4 * (c4 & 7); q[0] = v[i].x; q[1] = v[i].y; q[2] = v[i].z; q[3] = v[i].w; }
        }
        LDS_WAIT(); asm volatile("" ::: "memory");
#pragma unroll
        for (int j = 0; j < 4; ++j) { const int n = (lane >> 3) + 8 * j; const LAS float* s = scr + (8 * c) * 33 + n;
            v4u o; o.x = pk2(s[0 * 33], s[1 * 33]); o.y = pk2(s[2 * 33], s[3 * 33]); o.z = pk2(s[4 * 33], s[5 * 33]); o.w = pk2(s[6 * 33], s[7 * 33]);
            *(v4u*)(t.dst + (size_t)(32 * hf + n) * t.Kd + 8 * c) = o; }
        LDS_WAIT(); asm volatile("" ::: "memory");
    }
}
struct Dec0 { const float* w_in; bf16* WinT;
    __device__ __forceinline__ TI operator()(int r) const { const int nblk = NPROJ / 64, kb = r / nblk, nb = r % nblk; TI t; t.src = w_in + (size_t)(64 * kb) * NPROJ_ALL + 64 * nb; t.N = NPROJ_ALL; t.dst = WinT + (size_t)(64 * nb) * D + 64 * kb; t.Kd = D; return t; } };
struct Dec1 { const float *w_out, *w_gate, *w_up, *w_down; bf16 *WoT, *WguT, *WdT;
    __device__ __forceinline__ TI operator()(int r) const {
        constexpr int I_OUT = (D / 64) * (D / 64), I_G1 = (D / 64) * (FF / 64), I_G = NE * I_G1, I_D1 = (FF / 64) * (D / 64);
        TI t;
        if (r < I_OUT) { const int nblk = D / 64, kb = r / nblk, nb = r % nblk; t.src = w_out + (size_t)(64 * kb) * D + 64 * nb; t.N = D; t.dst = WoT + (size_t)(64 * nb) * D + 64 * kb; t.Kd = D; return t; }
        r -= I_OUT;
        if (r < 2 * I_G) { const int up = r >= I_G; if (up) r -= I_G; const int e = r / I_G1, q = r % I_G1, nblk = FF / 64, kb = q / nblk, nb = q % nblk, n0 = 64 * nb;
            const int drow = e * 2 * FF + (n0 >> 7) * 256 + up * 128 + (n0 & 127);
            t.src = (up ? w_up : w_gate) + (size_t)e * D * FF + (size_t)(64 * kb) * FF + n0; t.N = FF; t.dst = WguT + (size_t)drow * D + 64 * kb; t.Kd = D; return t; }
        r -= 2 * I_G;
        { const int e = r / I_D1, q = r % I_D1, nblk = D / 64, kb = q / nblk, nb = q % nblk;
          t.src = w_down + (size_t)e * FF * D + (size_t)(64 * kb) * D + 64 * nb; t.N = D; t.dst = WdT + ((size_t)e * D + 64 * nb) * FF + 64 * kb; t.Kd = FF; return t; }
    } };
template <class Dec>
__device__ __forceinline__ void conv_loop(const Dec dec, int total, int gw, int NGW, int lane, LAS float* scr) {
    int it = gw; if (it >= total) return;
    f32x4 va[16], vb[16];
    TI a = dec(it), b = a; t_issue(a, lane, va);
    for (;;) {
        const int itb = it + NGW; const bool hb = itb < total;
        if (hb) { b = dec(itb); t_issue(b, lane, vb); }
        t_finish(a, lane, va, scr);
        if (!hb) break;
        it = itb + NGW; const bool ha = it < total;
        if (ha) { a = dec(it); t_issue(a, lane, va); }
        t_finish(b, lane, vb, scr);
        if (!ha) break;
    }
}
template <int PART>
__device__ __forceinline__ void convert_weights(const Frame& F0) {
    PIN_FRAME(F);
    LAS float* scr = (LAS float*)(F.lds + RING_OFF + F.wave * 16384);
    const int gw = F.bx * NWAVES + F.wave, NGW = F.G * NWAVES;
    if (PART == 0) {
        conv_loop(Dec0{F.w_in, F.WinT}, (D / 64) * (NPROJ / 64), gw, NGW, F.lane, scr);
        for (int kb = gw; kb < D / 64; kb += NGW) transpose_item(F.w_in, NPROJ_ALL, F.WinT + (size_t)NPROJ * D, D, 64 * kb, NPROJ, scr, F.lane);
    } else {
        constexpr int TOTAL = (D / 64) * (D / 64);
        conv_loop(Dec1{F.w_out, F.w_gate, F.w_up, F.w_down, F.WoT, F.WguT, F.WdT}, TOTAL, gw, NGW, F.lane, scr);
    }
}
__device__ __forceinline__ void p0_prologue(const Frame& F0) {
    PIN_FRAME(F);
    const int gw = F.bx * NWAVES + F.wave, NGW = F.G * NWAVES;
    for (int m = gw; m < T; m += 2 * NGW) {
        const int m2 = m + NGW < T ? m + NGW : m;
        const f32x4* xa = (const f32x4*)(F.x + (size_t)m * D) + F.lane; const f32x4* xb = (const f32x4*)(F.x + (size_t)m2 * D) + F.lane; const f32x4* wr = (const f32x4*)F.norm_attn_w + F.lane;
        f32x4 va[16], vb[16]; float sa = 0.f, sb = 0.f;
#pragma unroll
        for (int j = 0; j < 16; ++j) { va[j] = xa[64 * j]; vb[j] = xb[64 * j]; }
#pragma unroll
        for (int j = 0; j < 16; ++j) { sa += (va[j].x * va[j].x + va[j].y * va[j].y) + (va[j].z * va[j].z + va[j].w * va[j].w); sb += (vb[j].x * vb[j].x + vb[j].y * vb[j].y) + (vb[j].z * vb[j].z + vb[j].w * vb[j].w); }
        const float ra = 1.0f / sqrtf(wave_sum(sa) * (1.f / D) + NORM_EPS), rb = 1.0f / sqrtf(wave_sum(sb) * (1.f / D) + NORM_EPS);
        unsigned long long* oa = (unsigned long long*)(F.Hb + (size_t)m * D) + F.lane; unsigned long long* ob = (unsigned long long*)(F.Hb + (size_t)m2 * D) + F.lane;
#pragma unroll
        for (int j = 0; j < 16; ++j) { const f32x4 w = wr[64 * j];
            oa[64 * j] = (unsigned long long)pk2(va[j].x * ra * w.x, va[j].y * ra * w.y) | ((unsigned long long)pk2(va[j].z * ra * w.z, va[j].w * ra * w.w) << 32);
            if (m2 != m) ob[64 * j] = (unsigned long long)pk2(vb[j].x * rb * w.x, vb[j].y * rb * w.y) | ((unsigned long long)pk2(vb[j].z * rb * w.z, vb[j].w * rb * w.w) << 32); }
    }
    for (int i = F.bx * 512 + F.tid; i < (D / 32) * 3 * 2 * 64; i += F.G * 512) {
        const int ln = i & 63, p = (i >> 6) & 1, nt = (i >> 7) % 3, st = (i >> 7) / 3, c = 16 * nt + (ln & 15), k0 = 32 * st + 8 * (ln >> 4);
        unsigned h[8];
#pragma unroll
        for (int j = 0; j < 8; ++j) { const int k = k0 + j;
            const float wv = F.norm_ffn_w[k] * (c < 4 ? F.rg_w[k * NGRP + c] : (c < 16 ? 0.f : F.re_w[k * NE + c - 16]));
            const unsigned hi = f2bf(wv); h[j] = p ? f2bf(wv - __uint_as_float(hi << 16)) : hi; }
        ((v4u*)F.RW)[i] = (v4u){h[0] | (h[1] << 16), h[2] | (h[3] << 16), h[4] | (h[5] << 16), h[6] | (h[7] << 16)}; }
}
__device__ __forceinline__ void p1_dt(const Frame& F0) {
    PIN_FRAME(F);
    LAS float* red = (LAS float*)(F.lds + RING_OFF);
    const int fr = F.lane & 15, fq = F.lane >> 4;
    for (int item = F.bx; item < T / 16; item += 2 * F.G) {
        const bool has2 = item + F.G < T / 16;
        const int rowA = item * 16, rowB = (has2 ? item + F.G : item) * 16, kbase = F.wave * 512;
        f32x4 a0 = {0.f, 0.f, 0.f, 0.f}, a1 = a0, c0 = a0, c1 = a0;
        const bf16* apA = F.Hb + (size_t)(rowA + fr) * D + kbase + 8 * fq;
        const bf16* apB = F.Hb + (size_t)(rowB + fr) * D + kbase + 8 * fq;
        const bf16* b0p = F.WinT + (size_t)(NPROJ + fr) * D + kbase + 8 * fq;
        const bf16* b1p = F.WinT + (size_t)(NPROJ + 16 + fr) * D + kbase + 8 * fq;
#pragma unroll 4
        for (int s = 0; s < 16; ++s) {
            const bf16x8 xa = *(const bf16x8*)(apA + 32 * s), xb = *(const bf16x8*)(apB + 32 * s), b0 = *(const bf16x8*)(b0p + 32 * s), b1 = *(const bf16x8*)(b1p + 32 * s);
            a0 = __builtin_amdgcn_mfma_f32_16x16x32_bf16(xa, b0, a0, 0, 0, 0); a1 = __builtin_amdgcn_mfma_f32_16x16x32_bf16(xa, b1, a1, 0, 0, 0);
            c0 = __builtin_amdgcn_mfma_f32_16x16x32_bf16(xb, b0, c0, 0, 0, 0); c1 = __builtin_amdgcn_mfma_f32_16x16x32_bf16(xb, b1, c1, 0, 0, 0);
        }
        *(LAS f32x4*)(red + ((F.wave * 2 + 0) * 64 + F.lane) * 4) = a0; *(LAS f32x4*)(red + ((F.wave * 2 + 1) * 64 + F.lane) * 4) = a1;
        *(LAS f32x4*)(red + 4096 + ((F.wave * 2 + 0) * 64 + F.lane) * 4) = c0; *(LAS f32x4*)(red + 4096 + ((F.wave * 2 + 1) * 64 + F.lane) * 4) = c1;
        __syncthreads();
#pragma unroll
        for (int it = 0; it < 2; ++it) { if (it == 1 && !has2) break;
          const int row = F.tid >> 5, col = F.tid & 31, nt = col >> 4, ln = (row >> 2) * 16 + (col & 15), rg = row & 3, row0 = it ? rowB : rowA;
          float v = 0.f;
#pragma unroll
          for (int w = 0; w < 8; ++w) v += red[it * 4096 + ((w * 2 + nt) * 64 + ln) * 4 + rg];
          v += F.dt_bias[col];
          const float dt = v > 20.f ? v : log1pf(expf(v));
          F.DT[(size_t)(row0 + row) * SH + col] = dt; F.DA[(size_t)(row0 + row) * SH + col] = -dt * expf(F.a_log[col]); }
        __syncthreads();
    }
}

__constant__ double c_invfreq_rev[64] = {
0.15915494309189535,0.13782250260398285,0.11934937021124886,0.10335229661843406,0.089499401608891013,0.077503288755374058,0.067115083005227255,0.058119267441876246,0.050329212104487035,0.04358330210530733,0.037741584717419771,0.032682865872356998,0.028302195830623399,0.024508691862069852,0.02122365276477766,0.018378926105679667,0.015915494309189534,0.013782250260398284,0.011934937021124886,0.010335229661843406,0.0089499401608891024,0.0077503288755374055,0.0067115083005227253,0.0058119267441876241,0.0050329212104487037,0.0043583302105307331,0.0037741584717419772,0.0032682865872356993,0.0028302195830623399,0.0024508691862069852,0.0021223652764777662,0.0018378926105679667,0.0015915494309189536,0.0013782250260398288,0.0011934937021124885,0.0010335229661843405,0.00089499401608891024,0.00077503288755374051,0.0006711508300522726,0.00058119267441876239,0.00050329212104487033,0.00043583302105307329,0.00037741584717419774,0.00032682865872356992,0.00028302195830623395,0.00024508691862069854,0.00021223652764777661,0.00018378926105679666,0.00015915494309189535,0.00013782250260398286,0.00011934937021124886,0.00010335229661843406,8.9499401608891018e-05,7.7503288755374056e-05,6.7115083005227254e-05,5.8119267441876239e-05,5.0329212104487035e-05,4.3583302105307322e-05,3.7741584717419777e-05,3.2682865872356999e-05,2.8302195830623396e-05,2.4508691862069852e-05,2.1223652764777659e-05,1.8378926105679668e-05};

struct QkRaw { v4u a0, a1, b0, b1; };
__device__ __forceinline__ QkRaw qk_load(const bf16* src, int lane) {
    const int hh = lane >> 2, sub = lane & 3;
    const v4u* p1 = (const v4u*)(src + hh * HD + 16 * sub); const v4u* p2 = (const v4u*)(src + hh * HD + 64 + 16 * sub);
    QkRaw r; r.a0 = p1[0]; r.a1 = p1[1]; r.b0 = p2[0]; r.b1 = p2[1]; return r;
}
__device__ __forceinline__ void qk_norm_rope(const QkRaw& raw, const float* nw, bf16* dst, const LAS float* cs, int lane) {
    const int hh = lane >> 2, sub = lane & 3;
    const v4u a0 = raw.a0, a1 = raw.a1, b0 = raw.b0, b1 = raw.b1;
    float t1[16], t2[16];
    { const unsigned aw[8] = {a0.x, a0.y, a0.z, a0.w, a1.x, a1.y, a1.z, a1.w}, bw[8] = {b0.x, b0.y, b0.z, b0.w, b1.x, b1.y, b1.z, b1.w};
#pragma unroll
      for (int i = 0; i < 8; ++i) { t1[2 * i] = bflo(aw[i]); t1[2 * i + 1] = bfhi(aw[i]); t2[2 * i] = bflo(bw[i]); t2[2 * i + 1] = bfhi(bw[i]); } }
    float s = 0.f;
#pragma unroll
    for (int i = 0; i < 16; ++i) s += t1[i] * t1[i] + t2[i] * t2[i];
    s += __shfl_xor(s, 1); s += __shfl_xor(s, 2);
    const float rstd = 1.0f / sqrtf(s * (1.f / HD) + NORM_EPS);
    unsigned o1[8], o2[8];
#pragma unroll
    for (int i = 0; i < 8; ++i) {
        float r1[2], r2[2];
#pragma unroll
        for (int e = 0; e < 2; ++e) { const int j = 2 * i + e, fi = 16 * sub + j; const float y1 = t1[j] * rstd * nw[fi], y2 = t2[j] * rstd * nw[64 + fi]; const float c = cs[fi], sn = cs[64 + fi];
            r1[e] = y1 * c - y2 * sn; r2[e] = y2 * c + y1 * sn; }
        o1[i] = pk2(r1[0], r1[1]); o2[i] = pk2(r2[0], r2[1]);
    }
    v4u* q1 = (v4u*)(dst + hh * HD + 16 * sub); v4u* q2 = (v4u*)(dst + hh * HD + 64 + 16 * sub);
    q1[0] = (v4u){o1[0], o1[1], o1[2], o1[3]}; q1[1] = (v4u){o1[4], o1[5], o1[6], o1[7]};
    q2[0] = (v4u){o2[0], o2[1], o2[2], o2[3]}; q2[1] = (v4u){o2[4], o2[5], o2[6], o2[7]};
}
__device__ __forceinline__ void p2_prep(const Frame& F0) {
    PIN_FRAME(F);
    const int gw = F.bx * NWAVES + F.wave, NGW = F.G * NWAVES;
    LAS float* cs = (LAS float*)(F.lds + RING_OFF + F.wave * 1024);
    for (int row = gw; row < T; row += 2 * NGW) {
        const int row2 = row + NGW < T ? row + NGW : row;
        const QkRaw qraw = qk_load(F.PROJ + (size_t)row * NPROJ + Q0, F.lane), kraw = qk_load(F.PROJ + (size_t)row * NPROJ + K0, F.lane);
        const QkRaw qraw2 = qk_load(F.PROJ + (size_t)row2 * NPROJ + Q0, F.lane), kraw2 = qk_load(F.PROJ + (size_t)row2 * NPROJ + K0, F.lane);
        const double r = (double)F.pos[row] * c_invfreq_rev[F.lane], r2 = (double)F.pos[row2] * c_invfreq_rev[F.lane];
        const float fr = (float)(r - floor(r)), fr2 = (float)(r2 - floor(r2));
        cs[F.lane] = __builtin_amdgcn_cosf(fr); cs[64 + F.lane] = __builtin_amdgcn_sinf(fr);
        cs[128 + F.lane] = __builtin_amdgcn_cosf(fr2); cs[192 + F.lane] = __builtin_amdgcn_sinf(fr2);
        LDS_WAIT(); asm volatile("" ::: "memory");
        qk_norm_rope(qraw, F.q_norm_w, F.QN + (size_t)row * AW, cs, F.lane);
        qk_norm_rope(kraw, F.k_norm_w, F.KN + (size_t)row * AW, cs, F.lane);
        if (row2 != row) {
            qk_norm_rope(qraw2, F.q_norm_w, F.QN + (size_t)row2 * AW, cs + 128, F.lane);
            qk_norm_rope(kraw2, F.k_norm_w, F.KN + (size_t)row2 * AW, cs + 128, F.lane); }
        LDS_WAIT(); asm volatile("" ::: "memory");
    }
    for (int it = F.bx * 512 + F.tid; it < (T / 32) * 512; it += F.G * 512) {
        const int rb = it >> 9, ch = (it & 511) * 8, row0 = rb * 32, s0 = row0 & (SEQ - 1);
        float w[4][8], bias[8];
#pragma unroll
        for (int j = 0; j < 4; ++j) { const f32x4 wa = *(const f32x4*)(F.conv_w + j * 4096 + ch), wb = *(const f32x4*)(F.conv_w + j * 4096 + ch + 4);
            w[j][0] = wa.x; w[j][1] = wa.y; w[j][2] = wa.z; w[j][3] = wa.w; w[j][4] = wb.x; w[j][5] = wb.y; w[j][6] = wb.z; w[j][7] = wb.w; }
        { const f32x4 ba = *(const f32x4*)(F.conv_b + ch), bb = *(const f32x4*)(F.conv_b + ch + 4); bias[0] = ba.x; bias[1] = ba.y; bias[2] = ba.z; bias[3] = ba.w; bias[4] = bb.x; bias[5] = bb.y; bias[6] = bb.z; bias[7] = bb.w; }
        v4u win0, win1, win2;
        const bf16* src = F.PROJ + (size_t)row0 * NPROJ + XBC0 + ch;
        const v4u zero = {0u, 0u, 0u, 0u};
        win0 = s0 ? *(const v4u*)(src - 3 * (size_t)NPROJ) : zero; win1 = s0 ? *(const v4u*)(src - 2 * (size_t)NPROJ) : zero; win2 = s0 ? *(const v4u*)(src - (size_t)NPROJ) : zero;
#pragma unroll 4
        for (int t = 0; t < 32; ++t) {
            const v4u cur = *(const v4u*)(src + (size_t)t * NPROJ);
            const unsigned a0[4] = {win0.x, win0.y, win0.z, win0.w}, a1[4] = {win1.x, win1.y, win1.z, win1.w}, a2[4] = {win2.x, win2.y, win2.z, win2.w}, a3[4] = {cur.x, cur.y, cur.z, cur.w};
            unsigned o[4];
#pragma unroll
            for (int i = 0; i < 4; ++i) {
                const float lo = bias[2 * i] + w[0][2 * i] * bflo(a0[i]) + w[1][2 * i] * bflo(a1[i]) + w[2][2 * i] * bflo(a2[i]) + w[3][2 * i] * bflo(a3[i]);
                const float hi = bias[2 * i + 1] + w[0][2 * i + 1] * bfhi(a0[i]) + w[1][2 * i + 1] * bfhi(a1[i]) + w[2][2 * i + 1] * bfhi(a2[i]) + w[3][2 * i + 1] * bfhi(a3[i]);
                o[i] = pk2(silu_f(lo), silu_f(hi));
            }
            *(v4u*)(F.XC + (size_t)(row0 + t) * 4096 + ch) = (v4u){o[0], o[1], o[2], o[3]};
            win0 = win1; win1 = win2; win2 = cur;
        }
    }
}

__device__ __forceinline__ void p3_attention_simple(const Frame& F0) {
    PIN_FRAME(F);
    const unsigned* QN32 = (const unsigned*)F.QN; const unsigned* KN32 = (const unsigned*)F.KN; const unsigned* PJ32 = (const unsigned*)F.PROJ;
    const float C2 = 0.08838834764831845f * 1.4426950408889634f;
    for (int item = F.bx * NWAVES + F.wave; item < T * NH; item += F.G * NWAVES) {
        const int s = item & (SEQ - 1), bh = item >> 11, h = bh & (NH - 1), b = bh >> 4, row = b * SEQ + s;
        const unsigned qw = QN32[(size_t)row * (AW / 2) + h * 64 + F.lane];
        const float q0 = bflo(qw) * C2, q1 = bfhi(qw) * C2;
        float m = -1e30f, l = 0.f, a0 = 0.f, a1 = 0.f;
#pragma unroll 1
        for (int br = 0; br < 3; ++br) {
            const int dil = br == 0 ? 1 : (br == 1 ? 4 : 16);
            int nk = s / dil; nk = (nk > 128 ? 128 : nk) + 1;
#pragma unroll 1
            for (int j0 = 0; j0 < nk; j0 += 8) {
                unsigned kw[8], vw[8];
#pragma unroll
                for (int u = 0; u < 8; ++u) { const int j = j0 + u, jj = j < nk ? j : 0; const size_t kr = (size_t)(row - jj * dil);
                    kw[u] = KN32[kr * (AW / 2) + h * 64 + F.lane]; vw[u] = PJ32[kr * (NPROJ / 2) + V0 / 2 + h * 64 + F.lane]; }
#pragma unroll
                for (int u = 0; u < 8; ++u) {
                    float sc = wave_sum(q0 * bflo(kw[u]) + q1 * bfhi(kw[u]));
                    if (j0 + u >= nk) sc = -__builtin_inff();
                    const float mn = fmaxf(m, sc), corr = __builtin_amdgcn_exp2f(m - mn), p = __builtin_amdgcn_exp2f(sc - mn);
                    l = l * corr + p; a0 = a0 * corr + p * bflo(vw[u]); a1 = a1 * corr + p * bfhi(vw[u]); m = mn;
                }
            }
        }
        const float inv = 1.0f / l;
        ((unsigned*)F.MIX)[(size_t)row * (D / 2) + h * 64 + F.lane] = pk2(a0 * inv, a1 * inv);
    }
}

namespace att {
constexpr float SCALE = 0.08838834764831845f;
constexpr float THR = 8.f;
constexpr int KVBLK = 64, SHM_K = 16384, SHM_V = 16384;
typedef float f32x16 __attribute__((ext_vector_type(16)));
typedef short s16x4 __attribute__((ext_vector_type(4)));
#define KSWZ(row, colB) ((row) * 256 + ((colB) ^ (((row) & 7) << 4)))
#define SBAR() __builtin_amdgcn_sched_barrier(0)
__device__ __forceinline__ int v_st(int k, int c) { const int kk = (k & ~0xC) | ((k & 4) << 1) | ((k & 8) >> 1); return ((kk >> 3) * 4 + (c >> 5)) * 512 + ((kk & 7) * 32 + (c & 31)) * 2; }
__device__ __forceinline__ int v_rd_base(int lane) { return ((lane & 3) << 3) | (((lane >> 2) & 3) << 6) | (((lane >> 4) & 1) << 5) | (((lane >> 5) & 1) << 8); }
constexpr int v_rd_off(int d0, int ks, int half) { return d0 * 512 + ks * 4096 + half * 2048; }
__device__ __forceinline__ int crow(int r, int hi) { return (r & 3) + 8 * (r >> 2) + 4 * hi; }
__device__ __forceinline__ unsigned cvtpk(float lo, float hi) { unsigned r; asm volatile("v_cvt_pk_bf16_f32 %0, %1, %2" : "=v"(r) : "v"(lo), "v"(hi)); return r; }
__device__ __forceinline__ void mask_tile(f32x16& p0, f32x16& p1, int dq, unsigned W) {
    const float NEG = -__builtin_inff();
#pragma unroll
    for (int r = 0; r < 16; ++r) {
        const int c = (r & 3) + 8 * (r >> 2);
        if ((unsigned)(dq - c) >= W) p0[r] = NEG;
        if ((unsigned)(dq - c - 32) >= W) p1[r] = NEG;
    }
}
__device__ __forceinline__ void partialSM(f32x16& p0, f32x16& p1, float& m_reg, float& mn, float& alpha) {
    float pmax = p0[0];
#pragma unroll
    for (int r = 1; r < 16; ++r) pmax = fmaxf(pmax, p0[r]);
#pragma unroll
    for (int r = 0; r < 16; ++r) pmax = fmaxf(pmax, p1[r]);
    { auto rr = __builtin_amdgcn_permlane32_swap(__float_as_uint(pmax), __float_as_uint(pmax), false, false);
      pmax = fmaxf(__uint_as_float(rr[0]), __uint_as_float(rr[1])); }
    constexpr float C2 = 1.4426950408889634f * SCALE;
    if (__builtin_expect(__all((pmax - m_reg) * SCALE <= THR), 1)) { mn = m_reg; alpha = 1.f; }
    else { mn = fmaxf(m_reg, pmax); alpha = __builtin_amdgcn_exp2f((m_reg - mn) * C2); m_reg = mn; }
    const float mnL = -mn * C2;
#pragma unroll
    for (int r = 0; r < 16; ++r) p0[r] = fmaf(p0[r], C2, mnL);
#pragma unroll
    for (int r = 0; r < 16; ++r) p1[r] = fmaf(p1[r], C2, mnL);
#pragma unroll
    for (int r = 0; r < 16; ++r) p0[r] = __builtin_amdgcn_exp2f(p0[r]);
}
#define ATT_PK4(P, B_, OUT) do { unsigned a0 = att::cvtpk(P[B_+0], P[B_+1]), a1 = att::cvtpk(P[B_+2], P[B_+3]);                          \
        unsigned b0 = att::cvtpk(P[B_+4], P[B_+5]), b1 = att::cvtpk(P[B_+6], P[B_+7]);                                             \
        auto r0 = __builtin_amdgcn_permlane32_swap(a0, b0, false, false); auto r1 = __builtin_amdgcn_permlane32_swap(a1, b1, false, false); \
        v4u w = {r0[0], r1[0], r0[1], r1[1]}; OUT = *reinterpret_cast<bf16x8*>(&w); } while (0)
__device__ __forceinline__ void finishSM(f32x16& p0, f32x16& p1, float alpha, float& l_reg, bf16x8& pa0, bf16x8& pa1, bf16x8& pa2, bf16x8& pa3) {
#pragma unroll
    for (int r = 0; r < 16; ++r) p1[r] = __builtin_amdgcn_exp2f(p1[r]);
    float ps = 0;
#pragma unroll
    for (int r = 0; r < 16; ++r) ps += p0[r];
#pragma unroll
    for (int r = 0; r < 16; ++r) ps += p1[r];
    { auto rr = __builtin_amdgcn_permlane32_swap(__float_as_uint(ps), __float_as_uint(ps), false, false);
      ps = __uint_as_float(rr[0]) + __uint_as_float(rr[1]); }
    l_reg = l_reg * alpha + ps;
    ATT_PK4(p0, 0, pa0); ATT_PK4(p0, 8, pa1); ATT_PK4(p1, 0, pa2); ATT_PK4(p1, 8, pa3);
}
__device__ __forceinline__ void qkt(f32x16& p0, f32x16& p1, const LAS unsigned char* klds, int r32, int hi, const bf16x8* qr) {
    p0 = f32x16{}; p1 = f32x16{};
    const LAS unsigned char* kb[4];
#pragma unroll
    for (int dd = 0; dd < 4; ++dd) kb[dd] = klds + KSWZ(r32, (dd * 16 + hi * 8) * 2);
#pragma unroll
    for (int d0 = 0; d0 < 8; ++d0) { const LAS unsigned char* a = kb[d0 & 3] + (d0 >> 2) * 128;
        const bf16x8 b0 = *reinterpret_cast<const LAS bf16x8*>(a);
        const bf16x8 b1 = *reinterpret_cast<const LAS bf16x8*>(a + 32 * 256);
        p0 = __builtin_amdgcn_mfma_f32_32x32x16_bf16(b0, qr[d0], p0, 0, 0, 0);
        p1 = __builtin_amdgcn_mfma_f32_32x32x16_bf16(b1, qr[d0], p1, 0, 0, 0); }
}
#define ATT_TRRD(dst, off) asm volatile("ds_read_b64_tr_b16 %0, %1 offset:%2" : "=&v"(dst) : "v"(vb0), "i"(off) : "memory")
#define ATT_PV_D0(o_, d0, q0, q1, q2, q3) do { att::s16x4 l0, l1, l2, l3, h0, h1, h2, h3; constexpr int b_ = att::v_rd_off(d0, 0, 0); \
        ATT_TRRD(l0, b_); ATT_TRRD(h0, b_ + 2048); ATT_TRRD(l1, b_ + 4096); ATT_TRRD(h1, b_ + 6144); ATT_TRRD(l2, b_ + 8192); ATT_TRRD(h2, b_ + 10240); ATT_TRRD(l3, b_ + 12288); ATT_TRRD(h3, b_ + 14336); \
        asm volatile("s_waitcnt lgkmcnt(0)" ::: "memory"); SBAR();   \
        o_ = __builtin_amdgcn_mfma_f32_32x32x16_bf16(q0, (bf16x8){l0[0], l0[1], l0[2], l0[3], h0[0], h0[1], h0[2], h0[3]}, o_, 0, 0, 0);   \
        o_ = __builtin_amdgcn_mfma_f32_32x32x16_bf16(q1, (bf16x8){l1[0], l1[1], l1[2], l1[3], h1[0], h1[1], h1[2], h1[3]}, o_, 0, 0, 0);   \
        o_ = __builtin_amdgcn_mfma_f32_32x32x16_bf16(q2, (bf16x8){l2[0], l2[1], l2[2], l2[3], h2[0], h2[1], h2[2], h2[3]}, o_, 0, 0, 0);   \
        o_ = __builtin_amdgcn_mfma_f32_32x32x16_bf16(q3, (bf16x8){l3[0], l3[1], l3[2], l3[3], h3[0], h3[1], h3[2], h3[3]}, o_, 0, 0, 0); } while (0)
}

struct AttUnit { int br, dil, n, h, kt0, NT, qlo; size_t rowb; };
__device__ __forceinline__ AttUnit att_decode(int u, int hw, int wv4) {
    AttUnit a; const int br = u >> 9, v = u & 511; int dil, b, r, n, hp;
    if (br == 0) { dil = 16; hp = v & 7; r = (v >> 3) & 15; b = v >> 7; n = 0; }
    else if (br == 1) { dil = 4; n = ((v >> 8) + v) & 3; hp = (v >> 2) & 7; r = (v >> 5) & 3; b = v >> 7; }
    else { dil = 1; n = ((v >> 8) * 8 + v) & 15; hp = (v >> 4) & 7; b = (v >> 7) & 3; r = 0; }
    a.br = br; a.dil = dil; a.n = n; a.h = 2 * hp + hw; a.kt0 = n == 0 ? 0 : (n - 1) * 2; a.NT = n == 0 ? 2 : 4;
    a.rowb = (size_t)b * SEQ + r; a.qlo = n * 128 + wv4 * 32; return a;
}
__device__ __forceinline__ void p3_attention_mfma(const Frame& F0) {
    PIN_FRAME(F);
    using att::f32x16;
    const int lane = F.lane, r32 = lane & 31, hi = lane >> 5, hw = F.wave >> 2, wv4 = F.wave & 3, th = F.tid & 255;
    LAS unsigned char* Vl = F.lds + RING_OFF + hw * 65536;
    LAS unsigned char* Kl = Vl + 2 * att::SHM_V;
    LAS float* wsf = (LAS float*)(F.lds + L_ATT) + F.wave * 64; LAS float* li_l = wsf; LAS float* al_l = wsf + 32;
    const int sr = th >> 4, sc = (th & 15) * 8;
    int kws[4], vst[4];
#pragma unroll
    for (int i = 0; i < 4; ++i) { kws[i] = KSWZ(sr + 16 * i, sc * 2); vst[i] = att::v_st(sr + 16 * i, sc); }
    const int vb_base = (int)(uintptr_t)Vl + att::v_rd_base(lane);
    int u = F.bx; if (u >= 1536) return;
    AttUnit cur = att_decode(u, hw, wv4);
    bf16x8 qr[8]; v4u sk[4], sv[4];
#define ATT_LOADQ(A_) do { const bf16* qp = F.QN + ((A_).rowb + (size_t)((A_).qlo + r32) * (A_).dil) * AW + (A_).h * HD + hi * 8; \
        _Pragma("unroll") for (int d0 = 0; d0 < 8; ++d0) qr[d0] = *(const bf16x8*)(qp + d0 * 16); } while (0)
#define ATT_LOAD(A_, t_) do { const int kb_ = ((A_).kt0 + (t_)) * 64; _Pragma("unroll") for (int i = 0; i < 4; ++i) { const size_t gr = (A_).rowb + (size_t)(kb_ + sr + 16 * i) * (A_).dil; \
        sk[i] = *(const v4u*)(F.KN + gr * AW + (A_).h * HD + sc); sv[i] = *(const v4u*)(F.PROJ + gr * NPROJ + V0 + (A_).h * HD + sc); } } while (0)
#define ATT_WRITE(bf_) do { _Pragma("unroll") for (int i = 0; i < 4; ++i) { *(LAS v4u*)(Kl + (bf_) * att::SHM_K + kws[i]) = sk[i]; *(LAS v4u*)(Vl + (bf_) * att::SHM_V + vst[i]) = sv[i]; } } while (0)
    ATT_LOADQ(cur); ATT_LOAD(cur, 0);
#pragma unroll 1
    for (;;) {
        const int un = u + F.G; const bool has = un < 1536; const AttUnit nxt = att_decode(has ? un : u, hw, wv4);
        const int NT = cur.NT, qlo = cur.qlo, qm = qlo + r32 - 4 * hi;
        ATT_WRITE(0);
        __syncthreads();
        float m_reg = -1e30f, l_reg = 0.f; f32x16 o[4] = {};
#pragma unroll 1
        for (int t = 0; t < NT; ++t) {
            const int bf = t & 1;
            if (t + 1 < NT) ATT_LOAD(cur, t + 1); else if (has) ATT_LOAD(nxt, 0);
            const int kb = (cur.kt0 + t) * 64;
            const bool act = (kb <= qlo + 31) && (kb + 63 >= qlo - 128);
            if (act) {
                f32x16 p0, p1; float mn, al; bf16x8 pa0, pa1, pa2, pa3;
                att::qkt(p0, p1, Kl + bf * att::SHM_K, r32, hi, qr);
                att::mask_tile(p0, p1, qm - kb, 129u);
                att::partialSM(p0, p1, m_reg, mn, al);
                if (__any(al < 1.f)) { if (hi == 0) al_l[r32] = al; asm volatile("s_waitcnt lgkmcnt(0)" ::: "memory");
#pragma unroll
                    for (int d_ = 0; d_ < 4; ++d_)
#pragma unroll
                        for (int rr = 0; rr < 16; ++rr) o[d_][rr] *= al_l[att::crow(rr, hi)];
                    asm volatile("s_waitcnt lgkmcnt(0)" ::: "memory"); }
                att::finishSM(p0, p1, al, l_reg, pa0, pa1, pa2, pa3);
                const int vb0 = vb_base + bf * att::SHM_V;
                ATT_PV_D0(o[0], 0, pa0, pa1, pa2, pa3); ATT_PV_D0(o[1], 1, pa0, pa1, pa2, pa3); ATT_PV_D0(o[2], 2, pa0, pa1, pa2, pa3); ATT_PV_D0(o[3], 3, pa0, pa1, pa2, pa3);
            }
            if (t + 1 < NT) ATT_WRITE(bf ^ 1);
            else if (has) ATT_LOADQ(nxt);
            __syncthreads();
        }
        if (hi == 0) li_l[r32] = l_reg;
        asm volatile("s_waitcnt lgkmcnt(0)" ::: "memory");
        bf16* Ob = F.OBR + (size_t)cur.br * T * AW + cur.h * HD;
#pragma unroll
        for (int rr = 0; rr < 16; ++rr) { const int orow = att::crow(rr, hi); const float rli = __builtin_amdgcn_rcpf(li_l[orow]);
            bf16* op = Ob + (cur.rowb + (size_t)(qlo + orow) * cur.dil) * AW;
#pragma unroll
            for (int d0 = 0; d0 < 4; ++d0) { const float vv = o[d0][rr] * rli; const float vn = __shfl_xor(vv, 1);
                if ((r32 & 1) == 0) *(unsigned*)(op + d0 * 32 + r32) = att::cvtpk(vv, vn); } }
        if (hi == 0) { float* mlp = F.ML + (((size_t)cur.br * T + cur.rowb + (size_t)(qlo + r32) * cur.dil) * NH + cur.h) * 2; *(f32x2*)mlp = (f32x2){m_reg, l_reg}; }
        asm volatile("s_waitcnt lgkmcnt(0)" ::: "memory");
        if (!has) break;
        cur = nxt; u = un;
    }
#undef ATT_LOADQ
#undef ATT_LOAD
#undef ATT_WRITE
}
__device__ __forceinline__ void p4_attn_combine(const Frame& F0) {
    PIN_FRAME(F);
    const int gw = F.bx * NWAVES + F.wave, NGW = F.G * NWAVES;
    constexpr float C2 = 1.4426950408889634f * att::SCALE;
#pragma unroll 2
    for (int row = gw; row < T; row += NGW) {
        const int hh = F.lane >> 2;
        f32x2 ml[3]; float M = -3e38f;
#pragma unroll
        for (int b_ = 0; b_ < 3; ++b_) { ml[b_] = *(const f32x2*)(F.ML + (((size_t)b_ * T + row) * NH + hh) * 2); M = fmaxf(M, ml[b_].x); }
        float w[3], ws = 0.f;
#pragma unroll
        for (int b_ = 0; b_ < 3; ++b_) { w[b_] = ml[b_].y * __builtin_amdgcn_exp2f((ml[b_].x - M) * C2); ws += w[b_]; }
        const float inv = 1.0f / ws;
        float acc[32];
#pragma unroll
        for (int i = 0; i < 32; ++i) acc[i] = 0.f;
#pragma unroll
        for (int b_ = 0; b_ < 3; ++b_) { const v4u* p = (const v4u*)(F.OBR + ((size_t)b_ * T + row) * AW + 32 * F.lane); const float wb = w[b_] * inv;
#pragma unroll
            for (int j = 0; j < 4; ++j) { const v4u q = p[j]; const unsigned qq[4] = {q.x, q.y, q.z, q.w};
#pragma unroll
                for (int e = 0; e < 4; ++e) { acc[8 * j + 2 * e] += wb * bflo(qq[e]); acc[8 * j + 2 * e + 1] += wb * bfhi(qq[e]); } } }
        v4u* op = (v4u*)(F.MIX + (size_t)row * D + 32 * F.lane);
#pragma unroll
        for (int j = 0; j < 4; ++j) op[j] = (v4u){pk2(acc[8 * j], acc[8 * j + 1]), pk2(acc[8 * j + 2], acc[8 * j + 3]), pk2(acc[8 * j + 4], acc[8 * j + 5]), pk2(acc[8 * j + 6], acc[8 * j + 7])};
    }
}

#define SSD_TRRD(dst, base, off) asm volatile("ds_read_b64_tr_b16 %0, %1 offset:%2" : "=&v"(dst) : "v"(base), "i"(off) : "memory")
#define SSD_MKFRAG(l_, h_) ((bf16x8){l_[0], l_[1], l_[2], l_[3], h_[0], h_[1], h_[2], h_[3]})
__device__ __forceinline__ void ssd_cumsum(const Frame& F, int row0, int g, LAS float* csL, float* ct_out) {
    if (F.wave < 4) { const int hh = F.wave; const float* dap = F.DA + (size_t)(row0 + 4 * F.lane) * SH + 4 * g + hh;
        const float a0 = dap[0], a1 = dap[SH], a2 = dap[2 * SH], a3 = dap[3 * SH];
        const float s1 = a0 + a1, s2 = s1 + a2, s3 = s2 + a3; float t = s3;
#pragma unroll
        for (int off = 1; off < 64; off <<= 1) { const float v = __shfl_up(t, off); if (F.lane >= off) t += v; }
        const float ex = t - s3;
        *(LAS f32x4*)(csL + hh * 256 + 4 * F.lane) = (f32x4){ex + a0, ex + s1, ex + s2, ex + s3};
        if (ct_out && F.lane == 63) ct_out[hh] = ex + s3; }
}
__device__ __forceinline__ v4u scale8(v4u q, float w) {
    v4u o; o.x = pk2(bflo(q.x) * w, bfhi(q.x) * w); o.y = pk2(bflo(q.y) * w, bfhi(q.y) * w); o.z = pk2(bflo(q.z) * w, bfhi(q.z) * w); o.w = pk2(bflo(q.w) * w, bfhi(q.w) * w); return o;
}
__device__ __forceinline__ void p3_ssd_states(const Frame& F0) {
    PIN_FRAME(F);
    using att::s16x4;
    LAS float* csL = (LAS float*)(F.lds + RING_OFF);
    LAS float* wL = (LAS float*)(F.lds + RING_OFF + 4096);
    LAS unsigned char* BT = F.lds + RING_OFF + 16384;
    LAS unsigned char* XT = F.lds + RING_OFF + 32768;
    const int lane = F.lane, r32 = lane & 31, hi = lane >> 5, sr = F.tid >> 4, sc = (F.tid & 15) * 8;
    for (int item = F.bx; item < NB * 8 * SG; item += F.G) {
        const int g = item & 7, c = (item >> 3) & 7, b = item >> 6, row0 = b * SEQ + c * 256;
        ssd_cumsum(F, row0, g, csL, F.CT + (size_t)(b * 8 + c) * SH + 4 * g);
        __syncthreads();
        for (int i = F.tid; i < 1024; i += NWAVES * 64) { const int hh = i >> 8, l = i & 255;
            wL[i] = F.DT[(size_t)(row0 + l) * SH + 4 * g + hh] * __expf(csL[hh * 256 + 255] - csL[i]); }
        __syncthreads();
        const int hh = F.wave >> 1, pb = F.wave & 1;
        const int vbB = (int)(uintptr_t)BT + att::v_rd_base(lane);
        const int vbX = (int)(uintptr_t)XT + (hh >> 1) * 16384 + ((hh & 1) * 2 + pb) * 512 + att::v_rd_base(lane);
        att::f32x16 acc[4] = {};
        v4u sb[2], sx[2][2];
#define SSDA_LOAD(j_) do { _Pragma("unroll") for (int i = 0; i < 2; ++i) { const int l = 64 * (j_) + sr + 32 * i; const bf16* rp = F.XC + (size_t)(row0 + l) * 4096; \
            sb[i] = *(const v4u*)(rp + 2048 + g * SN + sc); \
            _Pragma("unroll") for (int tt = 0; tt < 2; ++tt) sx[i][tt] = scale8(*(const v4u*)(rp + g * 256 + tt * 128 + sc), wL[(tt * 2 + (sc >> 6)) * 256 + l]); } } while (0)
        SSDA_LOAD(0);
        for (int j = 0; j < 4; ++j) {
#pragma unroll
            for (int i = 0; i < 2; ++i) { const int rl = sr + 32 * i;
                *(LAS v4u*)(BT + att::v_st(rl, sc)) = sb[i];
#pragma unroll
                for (int tt = 0; tt < 2; ++tt) *(LAS v4u*)(XT + tt * 16384 + att::v_st(rl, sc)) = sx[i][tt]; }
            __syncthreads();
            if (j + 1 < 4) SSDA_LOAD(j + 1);
#define SSDA_KS(ks) do { s16x4 al0, ah0, al1, ah1, al2, ah2, al3, ah3, xl, xh; \
            SSD_TRRD(al0, vbB, 0 * 512 + (ks) * 4096); SSD_TRRD(ah0, vbB, 0 * 512 + (ks) * 4096 + 2048); SSD_TRRD(al1, vbB, 1 * 512 + (ks) * 4096); SSD_TRRD(ah1, vbB, 1 * 512 + (ks) * 4096 + 2048); \
            SSD_TRRD(al2, vbB, 2 * 512 + (ks) * 4096); SSD_TRRD(ah2, vbB, 2 * 512 + (ks) * 4096 + 2048); SSD_TRRD(al3, vbB, 3 * 512 + (ks) * 4096); SSD_TRRD(ah3, vbB, 3 * 512 + (ks) * 4096 + 2048); \
            SSD_TRRD(xl, vbX, (ks) * 4096); SSD_TRRD(xh, vbX, (ks) * 4096 + 2048); \
            asm volatile("s_waitcnt lgkmcnt(0)" ::: "memory"); __builtin_amdgcn_sched_barrier(0); \
            const bf16x8 xf = SSD_MKFRAG(xl, xh); \
            acc[0] = __builtin_amdgcn_mfma_f32_32x32x16_bf16(SSD_MKFRAG(al0, ah0), xf, acc[0], 0, 0, 0); acc[1] = __builtin_amdgcn_mfma_f32_32x32x16_bf16(SSD_MKFRAG(al1, ah1), xf, acc[1], 0, 0, 0); \
            acc[2] = __builtin_amdgcn_mfma_f32_32x32x16_bf16(SSD_MKFRAG(al2, ah2), xf, acc[2], 0, 0, 0); acc[3] = __builtin_amdgcn_mfma_f32_32x32x16_bf16(SSD_MKFRAG(al3, ah3), xf, acc[3], 0, 0, 0); } while (0)
            SSDA_KS(0); SSDA_KS(1); SSDA_KS(2); SSDA_KS(3);
#undef SSDA_KS
            __syncthreads();
        }
#undef SSDA_LOAD
        float* stp = F.ST + ((size_t)((b * 8 + c) * SH + 4 * g + hh) * SP + 32 * pb + r32) * SN;
#pragma unroll
        for (int nb = 0; nb < 4; ++nb)
#pragma unroll
            for (int q = 0; q < 4; ++q) *(f32x4*)(stp + 32 * nb + 8 * q + 4 * hi) = (f32x4){acc[nb][4 * q], acc[nb][4 * q + 1], acc[nb][4 * q + 2], acc[nb][4 * q + 3]};
    }
}
__device__ __forceinline__ void p4_ssd_out(const Frame& F0) {
    PIN_FRAME(F);
    using att::f32x16;
    LAS float* csL = (LAS float*)(F.lds + L_SSD);
    LAS float* dtL = (LAS float*)(F.lds + L_SSD + 4096);
    LAS float* facL = (LAS float*)(F.lds + L_SSD + 8192);
    LAS unsigned char* BK = F.lds + RING_OFF;
    LAS unsigned char* PT = F.lds + RING_OFF + 65536;
    LAS unsigned char* VT = F.lds + RING_OFF + 81920;
    LAS float* ep = (LAS float*)(F.lds + RING_OFF + 65536 + F.wave * 8192);
    const int lane = F.lane, r32 = lane & 31, hi = lane >> 5, w = F.wave;
    const int vb_base = (int)(uintptr_t)VT + att::v_rd_base(lane);
#pragma unroll 1
    for (int item = F.bx; item < NB * 8 * SG; item += F.G) {
        const int g = item & 7, c = (item >> 3) & 7, b = item >> 6, row0 = b * SEQ + c * 256;
        ssd_cumsum(F, row0, g, csL, nullptr);
        for (int i = F.tid; i < 1024; i += NWAVES * 64) dtL[i] = F.DT[(size_t)(row0 + (i & 255)) * SH + 4 * g + (i >> 8)];
        if (F.tid < 32) { const int cp = F.tid >> 2, hh = F.tid & 3; float ctv[8];
#pragma unroll
            for (int j = 0; j < 8; ++j) ctv[j] = F.CT[(size_t)(b * 8 + j) * SH + 4 * g + hh];
            float e = 0.f;
#pragma unroll
            for (int j = 0; j < 8; ++j) e += (j > cp && j < c) ? ctv[j] : 0.f;
            facL[F.tid] = cp < c ? __expf(e) : 0.f; }
#pragma unroll 8
        for (int ch = F.tid; ch < 4096; ch += NWAVES * 64) { const int l = ch >> 4, pc = ch & 15;
            *(LAS v4u*)(BK + (l >> 6) * 16384 + KSWZ(l & 63, pc * 16)) = *(const v4u*)(F.XC + (size_t)(row0 + l) * 4096 + 2048 + g * SN + pc * 8); }
        bf16x8 qr[8];
        { const bf16* cp_ = F.XC + (size_t)(row0 + 32 * w + r32) * 4096 + 3072 + g * SN + hi * 8;
#pragma unroll
          for (int d0 = 0; d0 < 8; ++d0) qr[d0] = *(const bf16x8*)(cp_ + d0 * 16); }
        __syncthreads();
#pragma unroll 1
        for (int hh = 0; hh < 4; ++hh) {
            int tid_ = F.tid; asm volatile("" : "+v"(tid_));
            const int vr = tid_ >> 3, vc = (tid_ & 7) * 8;
            v4u svv[4];
#pragma unroll
            for (int j = 0; j < 4; ++j) svv[j] = *(const v4u*)(F.XC + (size_t)(row0 + 64 * j + vr) * 4096 + g * 256 + hh * 64 + vc);
            {
                f32x4 t0[2][7], t1[2][7];
#define SSDB_LD(q, cp) do { const int ch_ = tid_ + (q) * (NWAVES * 64), p_ = ch_ >> 4, nc_ = ch_ & 15; const int cq_ = (cp) < c ? (cp) : 0; \
                    const float* sp_ = F.ST + ((size_t)((b * 8 + cq_) * SH + 4 * g + hh) * SP + p_) * SN + 8 * nc_; t0[q][cp] = *(const f32x4*)sp_; t1[q][cp] = *(const f32x4*)(sp_ + 4); } while (0)
#define SSDB_ACC(q) do { const int ch_ = tid_ + (q) * (NWAVES * 64), p_ = ch_ >> 4, nc_ = ch_ & 15; f32x4 a0 = {0.f, 0.f, 0.f, 0.f}, a1 = {0.f, 0.f, 0.f, 0.f}; \
                    _Pragma("unroll") for (int cp = 0; cp < 7; ++cp) { if (cp < c) { const float f_ = facL[cp * 4 + hh]; a0 += f_ * t0[q][cp]; a1 += f_ * t1[q][cp]; } } \
                    *(LAS v4u*)(PT + KSWZ(p_, nc_ * 16)) = (v4u){pk2(a0.x, a0.y), pk2(a0.z, a0.w), pk2(a1.x, a1.y), pk2(a1.z, a1.w)}; } while (0)
#pragma unroll
                for (int cp = 0; cp < 7; ++cp) SSDB_LD(0, cp);
#pragma unroll
                for (int cp = 0; cp < 5; ++cp) SSDB_LD(1, cp);
                SSDB_ACC(0);
                SSDB_LD(1, 5); SSDB_LD(1, 6);
                SSDB_ACC(1);
#undef SSDB_LD
#undef SSDB_ACC
            }
#pragma unroll
            for (int j = 0; j < 4; ++j) *(LAS v4u*)(VT + (j >> 1) * 16384 + att::v_st(vr, vc + 64 * (j & 1))) = scale8(svv[j], dtL[hh * 256 + 64 * j + vr]);
            __syncthreads();
            f32x16 o[2] = {};
            {   const LAS unsigned char* kb[4];
#pragma unroll
                for (int dd = 0; dd < 4; ++dd) kb[dd] = PT + KSWZ(r32, (dd * 16 + hi * 8) * 2);
#pragma unroll
                for (int d0 = 0; d0 < 8; ++d0) { const LAS unsigned char* a = kb[d0 & 3] + (d0 >> 2) * 128;
                    const bf16x8 b0 = *reinterpret_cast<const LAS bf16x8*>(a), b1 = *reinterpret_cast<const LAS bf16x8*>(a + 32 * 256);
                    o[0] = __builtin_amdgcn_mfma_f32_32x32x16_bf16(qr[d0], b0, o[0], 0, 0, 0);
                    o[1] = __builtin_amdgcn_mfma_f32_32x32x16_bf16(qr[d0], b1, o[1], 0, 0, 0); }
#pragma unroll
                for (int rr = 0; rr < 16; ++rr) { const float e = __expf(csL[hh * 256 + 32 * w + att::crow(rr, hi)]); o[0][rr] *= e; o[1][rr] *= e; }
            }
            const float cl = csL[hh * 256 + 32 * w + r32];
#pragma unroll 1
            for (int j = 0; j < 4; ++j) {
                if (64 * j <= 32 * w + 31) {
                    f32x16 p0, p1;
                    att::qkt(p0, p1, BK + j * 16384, r32, hi, qr);
                    const int vb0 = vb_base + (j >> 1) * 16384;
                    const int dl = 32 * w + r32 - 64 * j - 4 * hi;
                    const LAS float* csk = csL + hh * 256 + 64 * j + 4 * hi;
#pragma unroll
                    for (int rr = 0; rr < 16; ++rr) { const int cc = (rr & 3) + 8 * (rr >> 2);
                        const float e0 = __builtin_amdgcn_exp2f((cl - csk[cc]) * 1.4426950408889634f), e1 = __builtin_amdgcn_exp2f((cl - csk[cc + 32]) * 1.4426950408889634f);
                        p0[rr] = (dl - cc >= 0) ? p0[rr] * e0 : 0.f; p1[rr] = (dl - cc - 32 >= 0) ? p1[rr] * e1 : 0.f; }
                    bf16x8 pa0, pa1, pa2, pa3;
                    ATT_PK4(p0, 0, pa0); ATT_PK4(p0, 8, pa1); ATT_PK4(p1, 0, pa2); ATT_PK4(p1, 8, pa3);
                    if (j & 1) { ATT_PV_D0(o[0], 2, pa0, pa1, pa2, pa3); ATT_PV_D0(o[1], 3, pa0, pa1, pa2, pa3); }
                    else { ATT_PV_D0(o[0], 0, pa0, pa1, pa2, pa3); ATT_PV_D0(o[1], 1, pa0, pa1, pa2, pa3); }
                }
            }
            __syncthreads();
#pragma unroll
            for (int d0 = 0; d0 < 2; ++d0)
#pragma unroll
                for (int rr = 0; rr < 16; ++rr) ep[att::crow(rr, hi) * 64 + d0 * 32 + r32] = o[d0][rr];
            LDS_WAIT(); asm volatile("" ::: "memory");
            { const int chn = g * 256 + hh * 64 + 8 * (lane & 7); const float dsk = F.d_skip[4 * g + hh];
              v4u xw[4], zw[4];
#pragma unroll
              for (int it = 0; it < 4; ++it) { const size_t row = (size_t)row0 + 32 * w + 8 * it + (lane >> 3);
                  xw[it] = *(const v4u*)(F.XC + row * 4096 + chn); zw[it] = *(const v4u*)(F.PROJ + row * NPROJ + Z0 + chn); }
#pragma unroll
              for (int it = 0; it < 4; ++it) { const int rr = 8 * it + (lane >> 3); const size_t row = (size_t)row0 + 32 * w + rr;
                  const f32x4 o0 = *(const LAS f32x4*)(ep + rr * 64 + 8 * (lane & 7)), o1 = *(const LAS f32x4*)(ep + rr * 64 + 8 * (lane & 7) + 4);
                  const unsigned xq[4] = {xw[it].x, xw[it].y, xw[it].z, xw[it].w}, zq[4] = {zw[it].x, zw[it].y, zw[it].z, zw[it].w};
                  f32x4 y0, y1;
                  y0.x = (o0.x + dsk * bflo(xq[0])) * silu_f(bflo(zq[0])); y0.y = (o0.y + dsk * bfhi(xq[0])) * silu_f(bfhi(zq[0]));
                  y0.z = (o0.z + dsk * bflo(xq[1])) * silu_f(bflo(zq[1])); y0.w = (o0.w + dsk * bfhi(xq[1])) * silu_f(bfhi(zq[1]));
                  y1.x = (o1.x + dsk * bflo(xq[2])) * silu_f(bflo(zq[2])); y1.y = (o1.y + dsk * bfhi(xq[2])) * silu_f(bfhi(zq[2]));
                  y1.z = (o1.z + dsk * bflo(xq[3])) * silu_f(bflo(zq[3])); y1.w = (o1.w + dsk * bfhi(xq[3])) * silu_f(bfhi(zq[3]));
                  *(f32x4*)(F.YG + row * SW + chn) = y0; *(f32x4*)(F.YG + row * SW + chn + 4) = y1; } }
            __syncthreads();
        }
        asm volatile("s_waitcnt vmcnt(0)" ::: "memory");
        { const f32x4 nw = *(const f32x4*)(F.ssd_norm_w + g * 256 + 4 * lane);
#pragma unroll 1
          for (int r8 = 0; r8 < 32; r8 += 16) { f32x4 v[16];
#pragma unroll
              for (int q = 0; q < 16; ++q) v[q] = *(const f32x4*)(F.YG + ((size_t)row0 + 32 * w + r8 + q) * SW + g * 256 + 4 * lane);
#pragma unroll
              for (int q = 0; q < 16; ++q) { const size_t row = (size_t)row0 + 32 * w + r8 + q;
                  const float ss = wave_sum((v[q].x * v[q].x + v[q].y * v[q].y) + (v[q].z * v[q].z + v[q].w * v[q].w));
                  const float rstd = 1.0f / sqrtf(ss * (1.f / 256.f) + SSD_NORM_EPS);
                  *(v2u*)(F.MIX + row * D + AW + g * 256 + 4 * lane) = (v2u){pk2(v[q].x * rstd * nw.x, v[q].y * rstd * nw.y), pk2(v[q].z * rstd * nw.z, v[q].w * rstd * nw.w)}; } } }
        __syncthreads();
    }
}
__device__ __forceinline__ void p3_ssd_simple(const Frame& F0) {
    PIN_FRAME(F);
    for (int item = F.bx; item < NB * SH; item += F.G) {
        const int b = item / SH, h = item % SH, g = h / (SH / SG), p = F.tid >> 3, ns = F.tid & 7;
        float st[16];
#pragma unroll
        for (int i = 0; i < 16; ++i) st[i] = 0.f;
        const float dsk = F.d_skip[h];
        const size_t r0 = (size_t)b * SEQ;
        v4u B0 = *(const v4u*)(F.XC + r0 * 4096 + 2048 + g * SN + 16 * ns), B1 = *(const v4u*)(F.XC + r0 * 4096 + 2048 + g * SN + 16 * ns + 8);
        v4u C0 = *(const v4u*)(F.XC + r0 * 4096 + 3072 + g * SN + 16 * ns), C1 = *(const v4u*)(F.XC + r0 * 4096 + 3072 + g * SN + 16 * ns + 8);
        bf16 xv = F.XC[r0 * 4096 + h * SP + p]; float dtv = F.DT[r0 * SH + h], dav = F.DA[r0 * SH + h]; bf16 zv = F.PROJ[r0 * NPROJ + Z0 + h * SP + p];
#pragma unroll 1
        for (int t = 0; t < SEQ; ++t) {
            const size_t rn = r0 + (t + 1 < SEQ ? t + 1 : t);
            const v4u nB0 = *(const v4u*)(F.XC + rn * 4096 + 2048 + g * SN + 16 * ns), nB1 = *(const v4u*)(F.XC + rn * 4096 + 2048 + g * SN + 16 * ns + 8);
            const v4u nC0 = *(const v4u*)(F.XC + rn * 4096 + 3072 + g * SN + 16 * ns), nC1 = *(const v4u*)(F.XC + rn * 4096 + 3072 + g * SN + 16 * ns + 8);
            const bf16 nxv = F.XC[rn * 4096 + h * SP + p]; const float ndt = F.DT[rn * SH + h], nda = F.DA[rn * SH + h]; const bf16 nzv = F.PROJ[rn * NPROJ + Z0 + h * SP + p];
            const float xval = bf2f(xv), decay = __expf(dav), coef = dtv * xval;
            const unsigned bw[8] = {B0.x, B0.y, B0.z, B0.w, B1.x, B1.y, B1.z, B1.w}, cw[8] = {C0.x, C0.y, C0.z, C0.w, C1.x, C1.y, C1.z, C1.w};
            float y = 0.f;
#pragma unroll
            for (int i = 0; i < 8; ++i) {
                st[2 * i] = decay * st[2 * i] + coef * bflo(bw[i]); st[2 * i + 1] = decay * st[2 * i + 1] + coef * bfhi(bw[i]);
                y += bflo(cw[i]) * st[2 * i] + bfhi(cw[i]) * st[2 * i + 1];
            }
            y += __shfl_xor(y, 1); y += __shfl_xor(y, 2); y += __shfl_xor(y, 4);
            if (ns == 0) { const float z = bf2f(zv); F.YG[(r0 + t) * SW + h * SP + p] = (y + dsk * xval) * silu_f(z); }
            B0 = nB0; B1 = nB1; C0 = nC0; C1 = nC1; xv = nxv; dtv = ndt; dav = nda; zv = nzv;
        }
    }
}
__device__ __forceinline__ void p4_groupnorm(const Frame& F0) {
    PIN_FRAME(F);
    const int gw = F.bx * NWAVES + F.wave, NGW = F.G * NWAVES;
    for (int row = gw; row < T; row += NGW) {
        const f32x4* yp = (const f32x4*)(F.YG + (size_t)row * SW + 32 * F.lane); const f32x4* wp = (const f32x4*)(F.ssd_norm_w + 32 * F.lane);
        f32x4 v[8]; float s = 0.f;
#pragma unroll
        for (int j = 0; j < 8; ++j) { v[j] = yp[j]; s += (v[j].x * v[j].x + v[j].y * v[j].y) + (v[j].z * v[j].z + v[j].w * v[j].w); }
        s += __shfl_xor(s, 1); s += __shfl_xor(s, 2); s += __shfl_xor(s, 4);
        const float rstd = 1.0f / sqrtf(s * (1.f / 256.f) + SSD_NORM_EPS);
        v4u* op = (v4u*)(F.MIX + (size_t)row * D + AW + 32 * F.lane);
#pragma unroll
        for (int j = 0; j < 4; ++j) { const f32x4 a = v[2 * j], c = v[2 * j + 1], wa = wp[2 * j], wc = wp[2 * j + 1];
            op[j] = (v4u){pk2(a.x * rstd * wa.x, a.y * rstd * wa.y), pk2(a.z * rstd * wa.z, a.w * rstd * wa.w), pk2(c.x * rstd * wc.x, c.y * rstd * wc.y), pk2(c.z * rstd * wc.z, c.w * rstd * wc.w)}; }
    }
}

__device__ __forceinline__ void p6_router_simple(const Frame& F0) {
    PIN_FRAME(F);
    const int gw = F.bx * NWAVES + F.wave, NGW = F.G * NWAVES;
    LAS float* hn = (LAS float*)(F.lds + RING_OFF + F.wave * 16384);
    unsigned* cnt = F.ctl + CW_CNT;
    for (int tok = gw; tok < T; tok += NGW) {
        const f32x4* xr = (const f32x4*)(F.out + (size_t)tok * D) + F.lane; const f32x4* wr = (const f32x4*)F.norm_ffn_w + F.lane;
        f32x4 v[16]; float s = 0.f;
#pragma unroll
        for (int j = 0; j < 16; ++j) { v[j] = xr[64 * j]; s += (v[j].x * v[j].x + v[j].y * v[j].y) + (v[j].z * v[j].z + v[j].w * v[j].w); }
        const float rstd = 1.0f / sqrtf(wave_sum(s) * (1.f / D) + NORM_EPS);
        unsigned long long* o8 = (unsigned long long*)(F.Hb + (size_t)tok * D) + F.lane;
#pragma unroll
        for (int j = 0; j < 16; ++j) { const f32x4 w = wr[64 * j]; f32x4 y; y.x = v[j].x * rstd * w.x; y.y = v[j].y * rstd * w.y; y.z = v[j].z * rstd * w.z; y.w = v[j].w * rstd * w.w;
            o8[64 * j] = (unsigned long long)pk2(y.x, y.y) | ((unsigned long long)pk2(y.z, y.w) << 32);
            *(LAS f32x4*)(hn + 4 * (F.lane + 64 * j)) = y;
            if ((j & 3) == 3) asm volatile("" ::: "memory"); }
        LDS_WAIT(); asm volatile("" ::: "memory");
        f32x4 ga = {0.f, 0.f, 0.f, 0.f};
        { const f32x4* gp = (const f32x4*)F.rg_w + F.lane;
#pragma unroll 8
          for (int c = 0; c < D / 64; ++c) { const f32x4 w = gp[64 * c]; const float hv = hn[F.lane + 64 * c]; ga.x += hv * w.x; ga.y += hv * w.y; ga.z += hv * w.z; ga.w += hv * w.w; } }
        float gl[4];
        gl[0] = wave_sum(ga.x) + F.rg_b[0]; gl[1] = wave_sum(ga.y) + F.rg_b[1]; gl[2] = wave_sum(ga.z) + F.rg_b[2]; gl[3] = wave_sum(ga.w) + F.rg_b[3];
        f32x4 ea = {0.f, 0.f, 0.f, 0.f};
        const f32x4* ep = (const f32x4*)F.re_w + F.lane;
#pragma unroll 8
        for (int c = 0; c < D / 8; ++c) { const f32x4 w = ep[64 * c]; const float hv = hn[8 * c + (F.lane >> 3)]; ea.x += hv * w.x; ea.y += hv * w.y; ea.z += hv * w.z; ea.w += hv * w.w; }
#pragma unroll
        for (int o = 8; o < 64; o <<= 1) { ea.x += __shfl_xor(ea.x, o); ea.y += __shfl_xor(ea.y, o); ea.z += __shfl_xor(ea.z, o); ea.w += __shfl_xor(ea.w, o); }
        int gi = 0; float gm = gl[0];
#pragma unroll
        for (int c = 1; c < 4; ++c) if (gl[c] > gm) { gm = gl[c]; gi = c; }
        float gs = 0.f;
#pragma unroll
        for (int c = 0; c < 4; ++c) gs += __expf(gl[c] - gm);
        const float g_p = 1.0f / gs;
        float e8[8];
#pragma unroll
        for (int i = 0; i < 8; ++i) { const int src = 2 * gi + (i >> 2); const float v0 = __shfl(ea.x, src), v1 = __shfl(ea.y, src), v2 = __shfl(ea.z, src), v3 = __shfl(ea.w, src);
            const int q = i & 3; e8[i] = (q == 0 ? v0 : q == 1 ? v1 : q == 2 ? v2 : v3) + F.re_b[gi * EPG + i]; }
        int i1 = 0; float m1 = e8[0];
#pragma unroll
        for (int i = 1; i < 8; ++i) if (e8[i] > m1) { m1 = e8[i]; i1 = i; }
        int i2 = -1; float m2 = -__builtin_inff();
#pragma unroll
        for (int i = 0; i < 8; ++i) if (i != i1 && e8[i] > m2) { m2 = e8[i]; i2 = i; }
        const float p2 = __expf(m2 - m1), den = 1.0f + p2;
        const float gate1 = g_p / den, gate2 = g_p * p2 / den;
        if (F.lane == 0) {
            const int e1 = gi * EPG + i1, e2 = gi * EPG + i2;
            const unsigned s1 = xb_add(cnt + e1, 1u), s2 = xb_add(cnt + e2, 1u);
            F.tok_e[2 * tok] = e1; F.tok_e[2 * tok + 1] = e2; F.tok_slot[2 * tok] = (int)s1; F.tok_slot[2 * tok + 1] = (int)s2;
            F.tok_gate[2 * tok] = gate1; F.tok_gate[2 * tok + 1] = gate2;
        }
        LDS_WAIT(); asm volatile("" ::: "memory");
    }
}

__device__ __forceinline__ void p6_router_mfma(const Frame& F0) {
    PIN_FRAME(F);
    LAS float* red = (LAS float*)(F.lds + RING_OFF);
    LAS float* ssq = (LAS float*)(F.lds + RING_OFF + 49152);
    LAS float* lg = (LAS float*)(F.lds + RING_OFF + 50176);
    LAS float* rs = (LAS float*)(F.lds + RING_OFF + 56320);
    unsigned* cnt = F.ctl + CW_CNT;
    const int lane = F.lane, row = lane & 15, kq = lane >> 4;
#pragma unroll 1
    for (int item = F.bx; item < T / 16; item += 2 * F.G) {
        const bool has2 = item + F.G < T / 16;
        const int tokA = item * 16, tokB = (has2 ? item + F.G : item) * 16, kbase = F.wave * 512;
        const bf16* apA = F.X1B + (size_t)(tokA + row) * D + kbase + 8 * kq;
        const bf16* apB = F.X1B + (size_t)(tokB + row) * D + kbase + 8 * kq;
        const bf16x8* tb = (const bf16x8*)F.RW + (size_t)(kbase / 32) * 384 + lane;
        f32x4 a0 = {0.f, 0.f, 0.f, 0.f}, a1 = a0, a2 = a0, b0 = a0, b1 = a0, b2 = a0; float ssA = 0.f, ssB = 0.f;
#define P6_SS(w_) ((bflo(w_.x) * bflo(w_.x) + bfhi(w_.x) * bfhi(w_.x)) + (bflo(w_.y) * bflo(w_.y) + bfhi(w_.y) * bfhi(w_.y)) + (bflo(w_.z) * bflo(w_.z) + bfhi(w_.z) * bfhi(w_.z)) + (bflo(w_.w) * bflo(w_.w) + bfhi(w_.w) * bfhi(w_.w)))
#pragma unroll 4
        for (int j = 0; j < 16; ++j) {
            const v4u wA = *(const v4u*)(apA + 32 * j), wB = *(const v4u*)(apB + 32 * j); const bf16x8* t = tb + j * 384;
            const bf16x8 f0h = t[0], f0l = t[64], f1h = t[128], f1l = t[192], f2h = t[256], f2l = t[320];
            const bf16x8 xA = __builtin_bit_cast(bf16x8, wA), xB = __builtin_bit_cast(bf16x8, wB);
            ssA += P6_SS(wA); ssB += P6_SS(wB);
            a0 = __builtin_amdgcn_mfma_f32_16x16x32_bf16(xA, f0h, a0, 0, 0, 0); a1 = __builtin_amdgcn_mfma_f32_16x16x32_bf16(xA, f1h, a1, 0, 0, 0); a2 = __builtin_amdgcn_mfma_f32_16x16x32_bf16(xA, f2h, a2, 0, 0, 0);
            b0 = __builtin_amdgcn_mfma_f32_16x16x32_bf16(xB, f0h, b0, 0, 0, 0); b1 = __builtin_amdgcn_mfma_f32_16x16x32_bf16(xB, f1h, b1, 0, 0, 0); b2 = __builtin_amdgcn_mfma_f32_16x16x32_bf16(xB, f2h, b2, 0, 0, 0);
            a0 = __builtin_amdgcn_mfma_f32_16x16x32_bf16(xA, f0l, a0, 0, 0, 0); a1 = __builtin_amdgcn_mfma_f32_16x16x32_bf16(xA, f1l, a1, 0, 0, 0); a2 = __builtin_amdgcn_mfma_f32_16x16x32_bf16(xA, f2l, a2, 0, 0, 0);
            b0 = __builtin_amdgcn_mfma_f32_16x16x32_bf16(xB, f0l, b0, 0, 0, 0); b1 = __builtin_amdgcn_mfma_f32_16x16x32_bf16(xB, f1l, b1, 0, 0, 0); b2 = __builtin_amdgcn_mfma_f32_16x16x32_bf16(xB, f2l, b2, 0, 0, 0);
        }
#undef P6_SS
        ssA += __shfl_xor(ssA, 16); ssA += __shfl_xor(ssA, 32); ssB += __shfl_xor(ssB, 16); ssB += __shfl_xor(ssB, 32);
        { LAS float* rA = red + ((F.wave * 3) * 64 + lane) * 4; LAS float* rB = rA + 6144;
          *(LAS f32x4*)(rA) = a0; *(LAS f32x4*)(rA + 256) = a1; *(LAS f32x4*)(rA + 512) = a2;
          *(LAS f32x4*)(rB) = b0; *(LAS f32x4*)(rB + 256) = b1; *(LAS f32x4*)(rB + 512) = b2; }
        if (lane < 16) { ssq[F.wave * 16 + lane] = ssA; ssq[128 + F.wave * 16 + lane] = ssB; }
        __syncthreads();
        for (int t2 = F.tid; t2 < 1536; t2 += NWAVES * 64) { const int it = t2 >= 768 ? 1 : 0, t = t2 - 768 * it, tl = t >> 8, ln = (t >> 2) & 63, rg = t & 3; float v = 0.f;
#pragma unroll
            for (int w = 0; w < 8; ++w) v += red[it * 6144 + ((w * 3 + tl) * 64 + ln) * 4 + rg];
            lg[(16 * it + 4 * (ln >> 4) + rg) * 48 + tl * 16 + (ln & 15)] = v; }
        if (F.tid < 32) { float q = 0.f;
#pragma unroll
            for (int w = 0; w < 8; ++w) q += ssq[(F.tid >> 4) * 128 + w * 16 + (F.tid & 15)];
            rs[F.tid] = 1.0f / sqrtf(q * (1.f / D) + NORM_EPS); }
        __syncthreads();
        if (F.tid < 32 && (F.tid < 16 || has2)) {
            const int tok = (F.tid < 16 ? tokA : tokB) + (F.tid & 15); const float rstd = rs[F.tid]; const LAS float* l = lg + F.tid * 48;
            int gi = 0; float gm = l[0] * rstd + F.rg_b[0];
            float glv[4]; glv[0] = gm;
#pragma unroll
            for (int c = 1; c < 4; ++c) { glv[c] = l[c] * rstd + F.rg_b[c]; if (glv[c] > gm) { gm = glv[c]; gi = c; } }
            float gs = 0.f;
#pragma unroll
            for (int c = 0; c < 4; ++c) gs += __expf(glv[c] - gm);
            const float g_p = 1.0f / gs;
            int i1 = 0, i2 = -1; float m1 = -__builtin_inff(), m2 = -__builtin_inff();
            for (int i = 0; i < 8; ++i) { const float v = l[16 + gi * EPG + i] * rstd + F.re_b[gi * EPG + i];
                if (v > m1) { m2 = m1; i2 = i1; m1 = v; i1 = i; } else if (v > m2) { m2 = v; i2 = i; } }
            const float p2 = __expf(m2 - m1), den = 1.0f + p2;
            const int e1 = gi * EPG + i1, e2 = gi * EPG + i2;
            const unsigned s1 = xb_add(cnt + e1, 1u), s2 = xb_add(cnt + e2, 1u);
            F.row_tok[e1 * ECAP + (int)s1] = 2 * tok; F.row_tok[e2 * ECAP + (int)s2] = 2 * tok + 1;
            F.row_gate[e1 * ECAP + (int)s1] = g_p / den; F.row_gate[e2 * ECAP + (int)s2] = g_p * p2 / den;
        }
#pragma unroll 1
        for (int u = 0; u < 4; ++u) { const int tk = 4 * F.wave + u; if (tk >= 16 && !has2) break; const float rstd = rs[tk]; const size_t trow = (size_t)((tk < 16 ? tokA : tokB) + (tk & 15));
            const v4u* xr = (const v4u*)(F.X1B + trow * D) + lane; const f32x4* wr = (const f32x4*)F.norm_ffn_w + 2 * lane;
            v4u* o8 = (v4u*)(F.Hb + trow * D) + lane;
#pragma unroll
            for (int j = 0; j < 8; ++j) { const v4u v = xr[64 * j]; const f32x4 w0 = wr[128 * j], w1 = wr[128 * j + 1];
                o8[64 * j] = (v4u){pk2(bflo(v.x) * rstd * w0.x, bfhi(v.x) * rstd * w0.y), pk2(bflo(v.y) * rstd * w0.z, bfhi(v.y) * rstd * w0.w),
                                   pk2(bflo(v.z) * rstd * w1.x, bfhi(v.z) * rstd * w1.y), pk2(bflo(v.w) * rstd * w1.z, bfhi(v.w) * rstd * w1.w)}; } }
        __syncthreads();
    }
}
__device__ __forceinline__ void moe_tables(Frame& F) {
    LAS int* tile_e = (LAS int*)(F.lds + L_TILE_E); LAS int* pstart = (LAS int*)(F.lds + L_PSTART); LAS int* lcnt = (LAS int*)(F.lds + L_CNT);
    LAS int* xe = (LAS int*)(F.lds + L_XE);
    if (F.tid < NE) lcnt[F.tid] = (int)xb_ld(F.ctl + CW_CNT + F.tid);
    __syncthreads();
    if (F.tid < NE) {
        int pre = 0, tot = 0, mine = 0;
#pragma unroll
        for (int e2 = 0; e2 < NE; ++e2) { const int n2 = (lcnt[e2] + 255) >> 8; pre += e2 < F.tid ? n2 : 0; tot += n2; mine = e2 == F.tid ? n2 : mine; }
        pstart[F.tid] = pre * 256;
        for (int j = 0; j < mine; ++j) tile_e[pre + j] = F.tid;
        if (F.tid == 0) { pstart[NE] = tot * 256; pstart[NE + 1] = tot; } }
    if (F.tid >= 64 && F.tid < 64 + NE) {
        const int me = F.tid - 64, my = (lcnt[me] + 255) >> 8; int rank = 0;
        for (int e2 = 0; e2 < NE; ++e2) { const int o = (lcnt[e2] + 255) >> 8; rank += (o > my || (o == my && e2 < me)) ? 1 : 0; }
        const int row = rank >> 3, col = rank & 7; xe[((row & 1) ? 7 - col : col) * 4 + row] = me; }
    __syncthreads();
    if (F.tid < 64) {
        int tl = 0;
        if (F.tid < 8) {
#pragma unroll
            for (int q = 0; q < 4; ++q) tl += (lcnt[xe[F.tid * 4 + q]] + 255) >> 8; }
#pragma unroll
        for (int o = 1; o < 8; o <<= 1) { const int other = __shfl_xor(tl, o); tl = other > tl ? other : tl; }
        if (F.tid == 0) pstart[NE + 2] = ((F.G % 8) != 0 || tl * 8 > 8 * (F.G / 8)) ? 1 : 0; }
    __syncthreads();
}
__device__ __forceinline__ void p7_gather(const Frame& F0) {
    PIN_FRAME(F);
    moe_tables(F);
    const LAS int* pstart = (const LAS int*)(F.lds + L_PSTART); const LAS int* lcnt = (const LAS int*)(F.lds + L_CNT);
    for (int a = F.bx * 512 + F.tid; a < 2 * T; a += F.G * 512) { const int dest = pstart[F.tok_e[a]] + F.tok_slot[a]; F.row_tok[dest] = a; F.row_gate[dest] = F.tok_gate[a]; }
    if (F.bx < NE) { const int e = F.bx, hi = pstart[e + 1] - pstart[e];
        for (int r = lcnt[e] + F.tid; r < hi; r += NWAVES * 64) { F.row_tok[pstart[e] + r] = -1; F.row_gate[pstart[e] + r] = 0.f; } }
}
__device__ __forceinline__ void p10_combine(const Frame& F0) {
    PIN_FRAME(F);
    const size_t n8 = (size_t)T * D / 8;
#pragma unroll 2
    for (size_t i = (size_t)F.bx * 512 + F.tid; i < n8; i += (size_t)F.G * 512) {
        const v4u x = ((const v4u*)F.X1B)[i], y0 = ((const v4u*)F.YS)[i], y1 = ((const v4u*)(F.YS + (size_t)T * D))[i];
        f32x4 a, b;
        a.x = bflo(x.x) + bflo(y0.x) + bflo(y1.x); a.y = bfhi(x.x) + bfhi(y0.x) + bfhi(y1.x); a.z = bflo(x.y) + bflo(y0.y) + bflo(y1.y); a.w = bfhi(x.y) + bfhi(y0.y) + bfhi(y1.y);
        b.x = bflo(x.z) + bflo(y0.z) + bflo(y1.z); b.y = bfhi(x.z) + bfhi(y0.z) + bfhi(y1.z); b.z = bflo(x.w) + bflo(y0.w) + bflo(y1.w); b.w = bfhi(x.w) + bfhi(y0.w) + bfhi(y1.w);
        ((f32x4*)F.out)[2 * i] = a; ((f32x4*)F.out)[2 * i + 1] = b;
    }
}

constexpr int NPHASE = 11;
__global__ void __launch_bounds__(NWAVES * 64, 2) hymba_fwd(Args args) {
    extern __shared__ __attribute__((aligned(16))) unsigned char lds_raw[];
    Frame F;
    F.lds = (LAS unsigned char*)lds_raw;
    F.tid = threadIdx.x; F.lane = F.tid & 63; F.wave = __builtin_amdgcn_readfirstlane(F.tid >> 6);
    F.G = gridDim.x; F.bx = blockIdx.x;
    unsigned char* ws = args.ws;
    F.ctl = (unsigned*)(ws + WS_CTL);
    F.x = (const float*)args.in[0]; F.pos = (const int*)args.in[1]; F.norm_attn_w = (const float*)args.in[2]; F.w_in = (const float*)args.in[3];
    F.q_norm_w = (const float*)args.in[4]; F.k_norm_w = (const float*)args.in[5]; F.conv_w = (const float*)args.in[6]; F.conv_b = (const float*)args.in[7];
    F.dt_bias = (const float*)args.in[8]; F.a_log = (const float*)args.in[9]; F.d_skip = (const float*)args.in[10]; F.ssd_norm_w = (const float*)args.in[11];
    F.w_out = (const float*)args.in[12]; F.norm_ffn_w = (const float*)args.in[13]; F.rg_w = (const float*)args.in[14]; F.rg_b = (const float*)args.in[15];
    F.re_w = (const float*)args.in[16]; F.re_b = (const float*)args.in[17]; F.w_gate = (const float*)args.in[18]; F.w_up = (const float*)args.in[19]; F.w_down = (const float*)args.in[20];
    F.out = args.out;
    F.WinT = (bf16*)(ws + WS_WIN); F.WoT = (bf16*)(ws + WS_WOUT); F.WguT = (bf16*)(ws + WS_WGU); F.WdT = (bf16*)(ws + WS_WD);
    F.Hb = (bf16*)(ws + WS_H); F.PROJ = (bf16*)(ws + WS_PROJ); F.XG = (bf16*)(ws + WS_PROJ); F.QN = (bf16*)(ws + WS_QN); F.KN = (bf16*)(ws + WS_KN); F.XC = (bf16*)(ws + WS_XC);
    F.DT = (float*)(ws + WS_DT); F.DA = (float*)(ws + WS_DA); F.YG = (float*)(ws + WS_YG); F.MIX = (bf16*)(ws + WS_MIX); F.ACT = (bf16*)(ws + WS_ACT); F.YS = (bf16*)(ws + WS_YS);
    F.OBR = (bf16*)(ws + WS_OBR); F.ML = (float*)(ws + WS_ML); F.ST = (float*)(ws + WS_ST); F.CT = (float*)(ws + WS_CT); F.RW = (float*)(ws + WS_RW); F.X1B = (bf16*)(ws + WS_PROJ);
    F.tok_e = (int*)(ws + WS_TOK); F.tok_slot = F.tok_e + 2 * T; F.tok_gate = (float*)(F.tok_slot + 2 * T);
    F.row_tok = (int*)(ws + WS_WGU); F.row_gate = (float*)(F.row_tok + NE * ECAP);
    for (int u = F.tid; u < (LDS_BYTES - LDSCTL_OFF) / 4; u += NWAVES * 64) ((LAS unsigned*)(F.lds + LDSCTL_OFF))[u] = 0u;
    __syncthreads();
    XcdBarrier bar; bar.bar = F.ctl + CW_BAR; bar.x = 0; bar.st = nullptr;
#if MK_ONE_LAUNCH
    bar = xcd_barrier_post(F.ctl + CW_BAR, (volatile LAS unsigned*)(F.lds + L_MISC) + 8);
#define GRID_BAR() xcd_barrier(bar)
#else
#define GRID_BAR() do { } while (0)
#endif
    const int lo = args.ph_lo, hi = args.ph_hi;
#ifndef PHMASK
#define PHMASK 0xFFFF
#endif
#define IN(k) (((PHMASK >> (k)) & 1) && lo <= (k) && (k) < hi)
#define SEAM(k) do { if (IN(k) && IN((k) + 1)) GRID_BAR(); } while (0)

    if (IN(0)) { convert_weights<0>(F); convert_weights<1>(F); p0_prologue(F); } SEAM(0);
    if (IN(1)) {
        pg8::Gemm g{F.Hb, F.WinT, D}; pg8::StaticOrder S; S.init(T, NPROJ, F.G, F.bx);
        pg8::EpiBf16 E{F.PROJ, NPROJ};
        pg8::gemm_phase<pg8::EpiBf16, pg8::StaticOrder>(F.lds + RING_OFF, g, S, E);
        __syncthreads();
        p1_dt(F);
    } SEAM(1);
    if (IN(2)) { p2_prep(F); } SEAM(2);
#if defined(ATT_SIMPLE)
    if (IN(3)) { p3_ssd_simple(F); p3_attention_simple(F); } SEAM(3);
    if (IN(4)) { p4_groupnorm(F); } SEAM(4);
#else
#if defined(SSD_SIMPLE)
    if (IN(3)) { p3_ssd_simple(F); p3_attention_mfma(F); } SEAM(3);
    if (IN(4)) { p4_groupnorm(F); p4_attn_combine(F); } SEAM(4);
#else
    if (IN(3)) { p3_ssd_states(F); __syncthreads(); p3_attention_mfma(F); } SEAM(3);
    if (IN(4)) { p4_ssd_out(F); p4_attn_combine(F); } SEAM(4);
#endif
#endif
    if (IN(5)) {
        pg8::Gemm g{F.MIX, F.WoT, D}; pg8::StaticOrder S; S.init(T, D, F.G, F.bx);
        pg8::EpiResidBf16 E{F.x, F.X1B, D};
        pg8::gemm_phase<pg8::EpiResidBf16, pg8::StaticOrder>(F.lds + RING_OFF, g, S, E);
    } SEAM(5);
#if defined(ROUTER_SIMPLE)
    if (IN(6)) { p6_router_simple(F); } SEAM(6);
#else
    if (IN(6)) { p6_router_mfma(F); } SEAM(6);
#endif
    if (IN(8)) {
        moe_tables(F);
        const int MT = ((const LAS int*)(F.lds + L_PSTART))[NE + 1];
        pg2::Moe2Order S{MT, FF / 128, F.G, F.bx, (const LAS int*)(F.lds + L_PSTART), ((const LAS int*)(F.lds + L_PSTART))[NE + 2], (const LAS int*)(F.lds + L_XE)};
        LAS unsigned* rowoff = (LAS unsigned*)(F.lds + L_SSD);
        { pg2::Unit2 u; for (int i = 0; i < 8; ++i) { if (!S.next(i, u)) break; if (F.tid < 256) { const LAS int* ps_ = (const LAS int*)(F.lds + L_PSTART); const LAS int* lc_ = (const LAS int*)(F.lds + L_CNT); const int s_ = (u.pm - (ps_[u.e] >> 8)) * 256 + F.tid; const int rt = s_ < lc_[u.e] ? F.row_tok[u.e * ECAP + s_] : -1; rowoff[i * 256 + F.tid] = (unsigned)(rt >= 0 ? rt >> 1 : 0) * (unsigned)(D * 2); } } }
        __syncthreads();
        pg3::EpiGateUp3 E{F.ACT, FF, F.ctl + CW_TILE};
        pg3::gemm3_phase<pg3::EpiGateUp3, pg2::Moe2Order, pg3::GateUpB, true>(F.lds + RING_OFF, F.Hb, D, S, pg3::GateUpB{F.w_gate, F.w_up}, E, (const LAS unsigned*)rowoff);
        __syncthreads();
        {
        const int flat2 = ((const LAS int*)(F.lds + L_PSTART))[NE + 2];
#ifdef DOWN_PG2
        pg2::Moe2OrderQ S2{MT, D / 128, F.bx, (const LAS int*)(F.lds + L_PSTART), flat2, (const LAS int*)(F.lds + L_XE), F.ctl + CW_TILE, F.ctl + 2, F.ctl + CW_DQ + 16 * (flat2 ? 0 : (F.bx & 7)), (LAS int*)(F.lds + L_XE + 128)};
        pg2::EpiDown2 E2{F.YS, D, T, F.row_tok, F.row_gate};
        pg2::gemm2_phase<pg2::EpiDown2, pg2::Moe2OrderQ, pg2::DownB, false>(F.lds + RING_OFF, F.ACT, FF, S2, pg2::DownB{F.w_down}, E2, nullptr);
#else
        pg2::Moe2OrderQ S2{MT, D / 256, F.bx, (const LAS int*)(F.lds + L_PSTART), flat2, (const LAS int*)(F.lds + L_XE), F.ctl + CW_TILE, F.ctl + 2, F.ctl + CW_DQ + 16 * (flat2 ? 0 : (F.bx & 7)), (LAS int*)(F.lds + L_XE + 128)};
        pg3::EpiDown3 E2{F.YS, D, T, F.row_tok, F.row_gate, (const LAS int*)(F.lds + L_PSTART), (const LAS int*)(F.lds + L_CNT)};
        pg3::gemm3_phase<pg3::EpiDown3, pg2::Moe2OrderQ, pg3::DownB3, false>(F.lds + RING_OFF, F.ACT, FF, S2, pg3::DownB3{F.w_down}, E2, nullptr);
#endif
        }
    } SEAM(9);
    if (IN(10)) { p10_combine(F); }
#undef IN
#undef SEAM
}

extern "C" void kernel_launch(void* const* d_in, const int* in_sizes, int n_in, void* d_out, int out_size, void* d_ws, size_t ws_size, hipStream_t stream) {
    static int grid = 0;
    if (grid == 0) {
        if (n_in != 21 || out_size != T * D || ws_size < WS_END) { fprintf(stderr, "kernel_launch: unexpected shapes (n_in %d out %d ws %zu, need %zu)\n", n_in, out_size, ws_size, (size_t)WS_END); grid = -1; return; }
        int dev = 0, cus = 0, per_cu = 0;
        if (hipGetDevice(&dev) != hipSuccess || hipDeviceGetAttribute(&cus, hipDeviceAttributeMultiprocessorCount, dev) != hipSuccess) { grid = -1; return; }
        if (hipFuncSetAttribute((const void*)hymba_fwd, hipFuncAttributeMaxDynamicSharedMemorySize, LDS_BYTES) != hipSuccess) { fprintf(stderr, "kernel_launch: hipFuncSetAttribute failed\n"); grid = -1; return; }
        if (hipOccupancyMaxActiveBlocksPerMultiprocessor(&per_cu, (const void*)hymba_fwd, NWAVES * 64, LDS_BYTES) != hipSuccess || per_cu < 1) { fprintf(stderr, "kernel_launch: occupancy query says %d\n", per_cu); (void)hipGetLastError(); }
        grid = cus;
    }
    if (grid < 0) return;
    (void)hipMemsetAsync((char*)d_ws + WS_CTL, 0, CTL_ZERO_BYTES, stream);
    Args a{};
    for (int i = 0; i < 21; ++i) a.in[i] = d_in[i];
    a.out = (float*)d_out; a.ws = (unsigned char*)d_ws;
#if MK_ONE_LAUNCH
    a.ph_lo = 0; a.ph_hi = NPHASE;
    hipLaunchKernelGGL(hymba_fwd, dim3(grid), dim3(NWAVES * 64), LDS_BYTES, stream, a);
#else
    for (int p = 0; p < NPHASE; ++p) { a.ph_lo = p; a.ph_hi = p + 1; hipLaunchKernelGGL(hymba_fwd, dim3(grid), dim3(NWAVES * 64), LDS_BYTES, stream, a); }
#endif
}
```

```cpp
#include <hip/hip_runtime.h>
#include <cstdio>
#include <cstdint>

#ifndef MK_ONE_LAUNCH
#define MK_ONE_LAUNCH 1
#endif

#define GAS __attribute__((address_space(1)))
#define LAS __attribute__((address_space(3)))
typedef unsigned short bf16;
typedef unsigned v4u __attribute__((ext_vector_type(4)));
typedef unsigned v2u __attribute__((ext_vector_type(2)));
typedef float f32x4 __attribute__((ext_vector_type(4)));
typedef float f32x2 __attribute__((ext_vector_type(2)));
typedef short bf16x8 __attribute__((ext_vector_type(8)));
#define LDS_WAIT() asm volatile("s_waitcnt lgkmcnt(0)" ::: "memory")
#define VM_WAIT() asm volatile("s_waitcnt vmcnt(0)" ::: "memory")

__device__ __forceinline__ float bflo(unsigned w) { return __uint_as_float(w << 16); }
__device__ __forceinline__ float bfhi(unsigned w) { return __uint_as_float(w & 0xffff0000u); }
__device__ __forceinline__ float bf2f(bf16 b) { return __uint_as_float(((unsigned)b) << 16); }
__device__ __forceinline__ unsigned f2bf(float f) { unsigned u = __float_as_uint(f); return (u + 0x7fffu + ((u >> 16) & 1u)) >> 16; }
__device__ __forceinline__ unsigned pk2(float lo, float hi) { return f2bf(lo) | (f2bf(hi) << 16); }
__device__ __forceinline__ float wave_sum(float v) {
#pragma unroll
    for (int o = 1; o < 64; o <<= 1) v += __shfl_xor(v, o);
    return v;
}
__device__ __forceinline__ float silu_f(float x) { return x / (1.0f + __expf(-x)); }

namespace pg8 {
#define PG8_LAS __attribute__((address_space(3)))
typedef unsigned short bf16_t;
typedef unsigned u32x4 __attribute__((ext_vector_type(4)));
constexpr int BM = 256, BK = 64, HALF = 128, HTB = HALF * BK * 2, STAGE_BYTES = 8 * HTB, NXCD = 8, WGM = 8;

__host__ __device__ __forceinline__ int lds_byte(int r, int c) { const int st = (r >> 4) * 2 + (c >> 5), rr = r & 15, cc = c & 31, ob = rr * 64 + cc * 2; return st * 1024 + (ob ^ (((ob >> 9) & 1) << 5)); }
__host__ __device__ __forceinline__ void stage_rc(int b, int& R, int& C) { const int st = b / 1024, sb = b % 1024, swz = sb ^ (((sb >> 9) & 1) << 5); R = (st >> 1) * 16 + swz / 64; C = (st & 1) * 32 + (swz % 64) / 2; }
__host__ __device__ __forceinline__ int perm32(int rho) { const int n = rho >> 4, i = rho & 15; return 8 * (i >> 2) + 4 * n + (i & 3); }

struct Unit { int pm, pn, pb; };
struct Gemm { const bf16_t* A; const bf16_t* Bt; int K; };

struct StaticOrder {
    int nM, nN, nwg, G, c;
    __device__ void init(int M, int N, int G_, int c_) { nM = M / BM; nN = N / BM; nwg = nM * nN; G = G_; c = c_; }
    __device__ bool next(int i, Unit& u) const {
        const long L = (long)i * G + c; if (L >= nwg) return false;
        int wgid = (int)L; { const int q = nwg / NXCD, r = nwg % NXCD, xcd = wgid % NXCD, off = wgid / NXCD; wgid = (xcd < r ? xcd * (q + 1) : r * (q + 1) + (xcd - r) * q) + off; }
        const int nig = WGM * nN, gid = wgid / nig, fm = gid * WGM, gsz = (nM - fm) < WGM ? (nM - fm) : WGM;
        u.pm = fm + ((wgid % nig) % gsz); u.pn = (wgid % nig) / gsz; u.pb = u.pn; return true;
    }
};
struct RangeOrder {
    StaticOrder S; int lo, hi;
    __device__ bool next(int i, Unit& u) const { return (lo + i < hi) && S.next(lo + i, u); }
};
struct MoeOrder {
    int MT, NT, G, c; const PG8_LAS int* pstart; int flat;
    __device__ bool next(int i, Unit& u) const {
        if (flat) { const long L = (long)i * G + c; if (L >= (long)MT * NT) return false; const int pn = (int)(L / MT), mt = (int)(L % MT);
            int e = 0; while (pstart[e + 1] <= mt * 256) ++e; u.pm = mt; u.pn = pn; u.pb = e * NT + pn; return true; }
        const int x = c & 7; int j = (c >> 3) + i * (G >> 3);
#pragma unroll
        for (int q = 0; q < 4; ++q) { const int e = x + 8 * q, t0 = pstart[e] >> 8, nm = (pstart[e + 1] >> 8) - t0, nu = nm * NT;
            if (j < nu) { const int pn = j / nm, mt = t0 + j % nm; u.pm = mt; u.pn = pn; u.pb = e * NT + pn; return true; }
            j -= nu; }
        return false;
    }
};

__device__ __forceinline__ unsigned cvt_pk_bf16(float lo, float hi) { unsigned r; asm volatile("v_cvt_pk_bf16_f32 %0, %1, %2" : "=v"(r) : "v"(lo), "v"(hi)); return r; }

struct EpiBf16 {
    static constexpr bool PERM = true;
    bf16_t* O; int ldc;
    __device__ __forceinline__ void operator()(const f32x4 (&acc)[2][2][4][2], const Unit& u, int wr, int wc, int fr, int fq) const {
        const int row0 = u.pm * BM + wr * 64 + fr, col0 = u.pn * BM + wc * 32 + 8 * fq;
#pragma unroll
        for (int ai = 0; ai < 2; ++ai)
#pragma unroll
            for (int m = 0; m < 4; ++m) { bf16_t* rowp = O + (size_t)(row0 + ai * HALF + m * 16) * ldc + col0;
#pragma unroll
                for (int bj = 0; bj < 2; ++bj) { const f32x4 v0 = acc[ai][bj][m][0], v1 = acc[ai][bj][m][1];
                    u32x4 w; w.x = cvt_pk_bf16(v0[0], v0[1]); w.y = cvt_pk_bf16(v0[2], v0[3]); w.z = cvt_pk_bf16(v1[0], v1[1]); w.w = cvt_pk_bf16(v1[2], v1[3]);
                    *(u32x4*)(rowp + bj * HALF) = w; } }
    }
};
struct EpiResid {
    static constexpr bool PERM = false;
    const float* base; float* out; int ldc;
    __device__ __forceinline__ void operator()(const f32x4 (&acc)[2][2][4][2], const Unit& u, int wr, int wc, int fr, int fq) const {
        const int row0 = u.pm * BM + wr * 64 + fr, col0 = u.pn * BM + wc * 32 + 4 * fq;
#pragma unroll
        for (int ai = 0; ai < 2; ++ai) {
            f32x4 b[4][2][2];
#pragma unroll
            for (int m = 0; m < 4; ++m) { const size_t off = (size_t)(row0 + ai * HALF + m * 16) * ldc + col0;
#pragma unroll
                for (int bj = 0; bj < 2; ++bj)
#pragma unroll
                    for (int n = 0; n < 2; ++n) b[m][bj][n] = *(const f32x4*)(base + off + bj * HALF + n * 16); }
#pragma unroll
            for (int m = 0; m < 4; ++m) { const size_t off = (size_t)(row0 + ai * HALF + m * 16) * ldc + col0;
#pragma unroll
                for (int bj = 0; bj < 2; ++bj)
#pragma unroll
                    for (int n = 0; n < 2; ++n) *(f32x4*)(out + off + bj * HALF + n * 16) = b[m][bj][n] + acc[ai][bj][m][n]; }
            asm volatile("" ::: "memory");
        }
    }
};
struct EpiResidBf16 {
    static constexpr bool PERM = true;
    const float* base; bf16_t* O; int ldc;
    __device__ __forceinline__ void operator()(const f32x4 (&acc)[2][2][4][2], const Unit& u, int wr, int wc, int fr, int fq) const {
        const int row0 = u.pm * BM + wr * 64 + fr, col0 = u.pn * BM + wc * 32 + 8 * fq;
#pragma unroll
        for (int ai = 0; ai < 2; ++ai) {
            f32x4 b[4][2][2];
#pragma unroll
            for (int m = 0; m < 4; ++m) { const size_t off = (size_t)(row0 + ai * HALF + m * 16) * ldc + col0;
#pragma unroll
                for (int bj = 0; bj < 2; ++bj)
#pragma unroll
                    for (int n = 0; n < 2; ++n) b[m][bj][n] = *(const f32x4*)(base + off + bj * HALF + n * 4); }
#pragma unroll
            for (int m = 0; m < 4; ++m) { const size_t off = (size_t)(row0 + ai * HALF + m * 16) * ldc + col0;
#pragma unroll
                for (int bj = 0; bj < 2; ++bj) { const f32x4 v0 = b[m][bj][0] + acc[ai][bj][m][0], v1 = b[m][bj][1] + acc[ai][bj][m][1];
                    u32x4 w; w.x = cvt_pk_bf16(v0[0], v0[1]); w.y = cvt_pk_bf16(v0[2], v0[3]); w.z = cvt_pk_bf16(v1[0], v1[1]); w.w = cvt_pk_bf16(v1[2], v1[3]);
                    *(u32x4*)(O + off + bj * HALF) = w; } }
            asm volatile("" ::: "memory");
        }
    }
};
struct EpiGateUp {
    static constexpr bool PERM = true;
    bf16_t* O; int ldc;
    __device__ __forceinline__ void operator()(const f32x4 (&acc)[2][2][4][2], const Unit& u, int wr, int wc, int fr, int fq) const {
        const int row0 = u.pm * BM + wr * 64 + fr, col0 = u.pn * HALF + wc * 32 + 8 * fq;
#pragma unroll
        for (int ai = 0; ai < 2; ++ai)
#pragma unroll
            for (int m = 0; m < 4; ++m) { bf16_t* rowp = O + (size_t)(row0 + ai * HALF + m * 16) * ldc + col0;
                float r[8];
#pragma unroll
                for (int n = 0; n < 2; ++n)
#pragma unroll
                    for (int j = 0; j < 4; ++j) { const float g = acc[ai][0][m][n][j], up = acc[ai][1][m][n][j]; r[n * 4 + j] = g * __builtin_amdgcn_rcpf(1.0f + __builtin_amdgcn_exp2f(-1.4426950408889634f * g)) * up; }
                u32x4 w; w.x = cvt_pk_bf16(r[0], r[1]); w.y = cvt_pk_bf16(r[2], r[3]); w.z = cvt_pk_bf16(r[4], r[5]); w.w = cvt_pk_bf16(r[6], r[7]);
                *(u32x4*)rowp = w; }
    }
};
struct EpiDown {
    static constexpr bool PERM = true;
    bf16_t* Y; int ldc; int T; const int* row_tok; const float* row_gate;
    __device__ __forceinline__ void operator()(const f32x4 (&acc)[2][2][4][2], const Unit& u, int wr, int wc, int fr, int fq) const {
        const int row0 = u.pm * BM + wr * 64 + fr, col0 = u.pn * BM + wc * 32 + 8 * fq;
#pragma unroll
        for (int ai = 0; ai < 2; ++ai)
#pragma unroll
            for (int m = 0; m < 4; ++m) { const int r = row0 + ai * HALF + m * 16; const int rt = row_tok[r]; const float gt = row_gate[r];
                if (rt >= 0) { bf16_t* rowp = Y + ((size_t)(rt & 1) * T + (size_t)(rt >> 1)) * ldc + col0;
#pragma unroll
                    for (int bj = 0; bj < 2; ++bj) { const f32x4 v0 = acc[ai][bj][m][0] * gt, v1 = acc[ai][bj][m][1] * gt;
                        u32x4 w; w.x = cvt_pk_bf16(v0[0], v0[1]); w.y = cvt_pk_bf16(v0[2], v0[3]); w.z = cvt_pk_bf16(v1[0], v1[1]); w.w = cvt_pk_bf16(v1[2], v1[3]);
                        *(u32x4*)(rowp + bj * HALF) = w; } } }
    }
};

template <class Epi, class Sched, bool ALIGN_EPI = true, bool GATHER = false>
__device__ __forceinline__ void gemm_phase(PG8_LAS unsigned char* lds, const Gemm g, const Sched& S, const Epi& E, const PG8_LAS unsigned* rowoff = nullptr) {
    const int tid = threadIdx.x, wid = __builtin_amdgcn_readfirstlane(tid >> 6), lane = tid & 63, wr = wid >> 2, wc = wid & 3, fr = lane & 15, fq = lane >> 4;
    const int K = g.K, nt = K / BK;
    unsigned voffA[2], voffB[2];
#pragma unroll
    for (int i = 0; i < 2; ++i) { int R, C; stage_rc(tid * 16 + i * 8192, R, C); const int Rb = Epi::PERM ? ((R & ~31) + perm32(R & 31)) : R;
        voffA[i] = (unsigned)(R * K + C) * 2u; voffB[i] = (unsigned)(Rb * K + C) * 2u; }
    const size_t kstep = (size_t)(BK * 2);
    int gR[2], gC[2];
#pragma unroll
    for (int i = 0; i < 2; ++i) { stage_rc(tid * 16 + i * 8192, gR[i], gC[i]); }
    unsigned c00 = 0, c01 = 0, c10 = 0, c11 = 0, n00 = 0, n01 = 0, n10 = 0, n11 = 0;
#define PG8_STAGE2(bufoff, gbase, o0, o1) do { \
        __builtin_amdgcn_global_load_lds((const unsigned*)((const char*)(gbase) + (o0)), (PG8_LAS unsigned*)(lds + (bufoff) + ldsw), 16, 0, 0); \
        __builtin_amdgcn_global_load_lds((const unsigned*)((const char*)(gbase) + (o1)), (PG8_LAS unsigned*)(lds + (bufoff) + ldsw + 8192), 16, 0, 0); } while (0)
#define PG8_GOFF(ui_, d00, d01, d10, d11) do { const PG8_LAS unsigned* r_ = rowoff + (ui_) * 256; d00 = r_[gR[0]] + gC[0] * 2; d01 = r_[gR[1]] + gC[1] * 2; d10 = r_[128 + gR[0]] + gC[0] * 2; d11 = r_[128 + gR[1]] + gC[1] * 2; } while (0)
    const size_t hstep = (size_t)HALF * K * 2;
    const size_t tstep = 2 * hstep;
    const unsigned ldsw = (unsigned)wid * 1024u;
    const int aoff = lds_byte(wr * 64 + fr, fq * 8), boff = lds_byte(wc * 32 + fr, fq * 8);
#define PG8_SA(b, h) (((b) * 2 + (h)) * HTB)
#define PG8_SB(b, h) ((4 + (b) * 2 + (h)) * HTB)
#define PG8_STAGE(bufoff, gbase, voff) do { _Pragma("unroll") for (int _i = 0; _i < 2; ++_i) \
        __builtin_amdgcn_global_load_lds((const unsigned*)((const char*)(gbase) + (voff)[_i]), (PG8_LAS unsigned*)(lds + (bufoff) + ldsw + _i * 8192), 16, 0, 0); } while (0)
#define PG8_LDA(dst, b, h) do { _Pragma("unroll") for (int m = 0; m < 4; ++m) _Pragma("unroll") for (int k = 0; k < 2; ++k) dst[m][k] = *(const PG8_LAS bf16x8*)(lds + PG8_SA(b, h) + aoff + m * 2048 + k * 1024); } while (0)
#define PG8_LDB(dst, b, h) do { _Pragma("unroll") for (int n = 0; n < 2; ++n) _Pragma("unroll") for (int k = 0; k < 2; ++k) dst[n][k] = *(const PG8_LAS bf16x8*)(lds + PG8_SB(b, h) + boff + n * 2048 + k * 1024); } while (0)
#define PG8_MMA(ai, bj, At, Bt) do { __builtin_amdgcn_s_setprio(1); _Pragma("unroll") for (int m = 0; m < 4; ++m) _Pragma("unroll") for (int n = 0; n < 2; ++n) _Pragma("unroll") for (int k = 0; k < 2; ++k) \
        acc[ai][bj][m][n] = __builtin_amdgcn_mfma_f32_16x16x32_bf16(Bt[n][k], At[m][k], acc[ai][bj][m][n], 0, 0, 0); __builtin_amdgcn_s_setprio(0); } while (0)
#define PG8_WAIT_V(n) asm volatile("s_waitcnt vmcnt(" #n ")" ::: "memory")
#define PG8_WAIT_L(n) asm volatile("s_waitcnt lgkmcnt(" #n ")" ::: "memory")
#define PG8_BAR __builtin_amdgcn_s_barrier()
#define PG8_SCHED __builtin_amdgcn_sched_barrier(0)
    Unit cur, nxt; int ui = 0;
    if (!S.next(0, cur)) return;
    f32x4 acc[2][2][4][2];
#pragma unroll
    for (int a = 0; a < 2; ++a)
#pragma unroll
        for (int b = 0; b < 2; ++b)
#pragma unroll
            for (int m = 0; m < 4; ++m)
#pragma unroll
                for (int n = 0; n < 2; ++n) acc[a][b][m][n] = (f32x4){0.f, 0.f, 0.f, 0.f};
    bf16x8 At[4][2], B0[2][2], B1[2][2];
    const char* cA = GATHER ? (const char*)g.A : (const char*)g.A + (size_t)cur.pm * tstep; const char* cB = (const char*)g.Bt + (size_t)cur.pb * tstep;
    if constexpr (GATHER) { PG8_GOFF(0, c00, c01, c10, c11); n00 = c00; n01 = c01; n10 = c10; n11 = c11; }
    PG8_STAGE(PG8_SB(0, 0), cB, voffB); PG8_STAGE(PG8_SB(0, 1), cB + hstep, voffB);
    if constexpr (GATHER) { PG8_STAGE2(PG8_SA(0, 0), cA, c00, c01); PG8_STAGE2(PG8_SA(0, 1), cA, c10, c11); } else { PG8_STAGE(PG8_SA(0, 0), cA, voffA); PG8_STAGE(PG8_SA(0, 1), cA + hstep, voffA); }
    if (wr == 1) PG8_BAR;
    PG8_WAIT_V(2); PG8_BAR;
    PG8_STAGE(PG8_SB(1, 0), cB + kstep, voffB); if constexpr (GATHER) PG8_STAGE2(PG8_SA(1, 0), cA + kstep, c00, c01); else PG8_STAGE(PG8_SA(1, 0), cA + kstep, voffA); PG8_STAGE(PG8_SB(1, 1), cB + hstep + kstep, voffB);
    PG8_WAIT_V(6); PG8_BAR;
    for (;;) {
        const bool has_next = S.next(ui + 1, nxt);
        const char* nA = GATHER ? (const char*)g.A : (has_next ? (const char*)g.A + (size_t)nxt.pm * tstep : cA); const char* nB = has_next ? (const char*)g.Bt + (size_t)nxt.pb * tstep : cB;
        if constexpr (GATHER) { if (has_next) PG8_GOFF(ui + 1, n00, n01, n10, n11); }
        for (int t = 0; t < nt; t += 2) {
            const bool last = (t == nt - 2);
            const char* a1 = cA + (size_t)(t + 1) * kstep;
            const char* a2 = last ? nA : cA + (size_t)(t + 2) * kstep; const char* b2 = last ? nB : cB + (size_t)(t + 2) * kstep;
            const char* a3 = a2 + kstep; const char* b3 = b2 + kstep;
            PG8_LDB(B0, 0, 0); PG8_LDB(B1, 0, 1); PG8_SCHED; PG8_LDA(At, 0, 0); if constexpr (GATHER) PG8_STAGE2(PG8_SA(1, 1), a1, c10, c11); else PG8_STAGE(PG8_SA(1, 1), a1 + hstep, voffA);
            PG8_WAIT_V(8); PG8_WAIT_L(0); PG8_BAR; PG8_MMA(0, 0, At, B0); PG8_MMA(0, 1, At, B1); PG8_BAR; PG8_SCHED;
            PG8_LDA(At, 0, 1); PG8_STAGE(PG8_SB(0, 0), b2, voffB); PG8_STAGE(PG8_SB(0, 1), b2 + hstep, voffB); if constexpr (GATHER) PG8_STAGE2(PG8_SA(0, 0), a2, last ? n00 : c00, last ? n01 : c01); else PG8_STAGE(PG8_SA(0, 0), a2, voffA);
            PG8_WAIT_V(8); PG8_WAIT_L(0); PG8_BAR; PG8_MMA(1, 0, At, B0); PG8_MMA(1, 1, At, B1); PG8_BAR; PG8_SCHED;
            PG8_LDB(B0, 1, 0); PG8_LDB(B1, 1, 1); PG8_SCHED; PG8_LDA(At, 1, 0); if constexpr (GATHER) PG8_STAGE2(PG8_SA(0, 1), a2, last ? n10 : c10, last ? n11 : c11); else PG8_STAGE(PG8_SA(0, 1), a2 + hstep, voffA);
            PG8_WAIT_V(8); PG8_WAIT_L(0); PG8_BAR; PG8_MMA(0, 0, At, B0); PG8_MMA(0, 1, At, B1); PG8_BAR; PG8_SCHED;
            PG8_LDA(At, 1, 1); PG8_STAGE(PG8_SB(1, 0), b3, voffB); PG8_STAGE(PG8_SB(1, 1), b3 + hstep, voffB); if constexpr (GATHER) PG8_STAGE2(PG8_SA(1, 0), a3, last ? n00 : c00, last ? n01 : c01); else PG8_STAGE(PG8_SA(1, 0), a3, voffA);
            PG8_WAIT_V(8); PG8_WAIT_L(0); PG8_BAR; PG8_MMA(1, 0, At, B0); PG8_MMA(1, 1, At, B1); PG8_BAR; PG8_SCHED;
        }
        if constexpr (ALIGN_EPI) { if (wr == 0) PG8_BAR; }
        E(acc, cur, wr, wc, fr, fq);
        if (!has_next) break;
#pragma unroll
        for (int a = 0; a < 2; ++a)
#pragma unroll
            for (int b = 0; b < 2; ++b)
#pragma unroll
                for (int m = 0; m < 4; ++m)
#pragma unroll
                    for (int n = 0; n < 2; ++n) acc[a][b][m][n] = (f32x4){0.f, 0.f, 0.f, 0.f};
        cur = nxt; cA = nA; cB = nB; ++ui; if constexpr (GATHER) { c00 = n00; c01 = n01; c10 = n10; c11 = n11; }
        if constexpr (ALIGN_EPI) { if (wr == 1) PG8_BAR; }
    }
    PG8_WAIT_V(0);
    if constexpr (!ALIGN_EPI) { if (wr == 0) PG8_BAR; }
    PG8_BAR;
#undef PG8_SA
#undef PG8_SB
#undef PG8_STAGE
#undef PG8_STAGE2
#undef PG8_GOFF
#undef PG8_LDA
#undef PG8_LDB
#undef PG8_MMA
#undef PG8_WAIT_V
#undef PG8_WAIT_L
#undef PG8_BAR
#undef PG8_SCHED
}
}
#define D_MODEL_ 4096
#define FF_ 1024
#define ECAP_ 8192

namespace pg2 {
using pg8::lds_byte; using pg8::stage_rc; using pg8::cvt_pk_bf16;
typedef short s16x4 __attribute__((ext_vector_type(4)));
constexpr int HTB = 16384, PB = 288, BBUF = 64 * PB, BOFF = 6 * HTB;
struct Unit2 { int pm, pn, e, half; };
struct Moe2Order {
    static constexpr bool DYNAMIC = false;
    int MT, NT, G, c; const LAS int* pstart; int flat; const LAS int* xe;
    __device__ bool next(int i, Unit2& u) const {
        if (flat) { const long L = (long)i * G + c; if (L >= (long)MT * NT) return false; const int pn = (int)(L / MT), mt = (int)(L % MT);
            int e = 0; while (pstart[e + 1] <= mt * 256) ++e; u.pm = mt; u.pn = pn; u.e = e; u.half = 0; return true; }
        const int x = c & 7; int j = (c >> 3) + i * (G >> 3);
#pragma unroll
        for (int q = 0; q < 4; ++q) { const int e = xe[x * 4 + q], t0 = pstart[e] >> 8, nm = (pstart[e + 1] >> 8) - t0, nu = nm * NT;
            if (j < nu) { u.pn = j / nm; u.pm = t0 + j % nm; u.e = e; u.half = 0; return true; }
            j -= nu; }
        return false;
    }
    __device__ __forceinline__ void wait_tile(int) const {}
};
struct Moe2OrderQ {
    static constexpr bool DYNAMIC = true;
    int MT, NT, c; const LAS int* pstart; int flat; const LAS int* xe; unsigned* tile_cnt; unsigned* tmo; unsigned* q; LAS int* slot;
    __device__ __forceinline__ bool decode(int j, Unit2& u) const {
        if (flat) { if (j >= MT * NT) return false; const int pn = j / MT, mt = j % MT;
            int e = 0; while (pstart[e + 1] <= mt * 256) ++e; u.pm = mt; u.pn = pn; u.e = e; u.half = 0; return true; }
        const int x = c & 7;
#pragma unroll
        for (int q_ = 0; q_ < 4; ++q_) { const int e = xe[x * 4 + q_], t0 = pstart[e] >> 8, nm = (pstart[e + 1] >> 8) - t0, nu = nm * NT;
            if (j < nu) { u.pn = j / nm; u.pm = t0 + j % nm; u.e = e; u.half = 0; return true; }
            j -= nu; }
        return false;
    }
    __device__ __forceinline__ unsigned grab() const { return __hip_atomic_fetch_add(q, 1u, __ATOMIC_RELAXED, __HIP_MEMORY_SCOPE_AGENT); }
    __device__ __forceinline__ void wait_tile(int pm) const {
        unsigned sp = 0;
        while ((unsigned)__builtin_amdgcn_readfirstlane(__hip_atomic_load(tile_cnt + 16 * pm, __ATOMIC_RELAXED, __HIP_MEMORY_SCOPE_AGENT)) < 64u) {
            __builtin_amdgcn_s_sleep(2);
            if (++sp > (1u << 22)) { if ((threadIdx.x & 63) == 0) __hip_atomic_store(tmo, 1u, __ATOMIC_RELAXED, __HIP_MEMORY_SCOPE_AGENT); break; } }
        __builtin_amdgcn_fence(__ATOMIC_ACQUIRE, "agent");
        asm volatile("s_waitcnt vmcnt(0)" ::: "memory");
    }
};
struct DownB { const float* w; __device__ __forceinline__ const float* operator()(int e, int pn, int c4, int& ldb) const { ldb = D_MODEL_; return w + (size_t)e * FF_ * D_MODEL_ + 128 * pn + 4 * c4; } };
struct EpiDown2 {
    bf16* Y; int ldc; int T; const int* row_tok; const float* row_gate;
    __device__ __forceinline__ void operator()(const f32x4 (&acc)[4][4], const Unit2& u, int wr, int wc, int fr, int fq) const {
#pragma unroll
        for (int m = 0; m < 4; ++m) { const int r = u.pm * 256 + wr * 64 + m * 16 + fr; const int rt = row_tok[r]; const float gt = row_gate[r];
            if (rt >= 0) { bf16* rowp = Y + ((size_t)(rt & 1) * T + (size_t)(rt >> 1)) * ldc + u.pn * 128 + wc * 64 + 4 * fq;
#pragma unroll
                for (int n = 0; n < 4; ++n) { const f32x4 v = acc[m][n] * gt; *(v2u*)(rowp + 16 * n) = (v2u){cvt_pk_bf16(v[0], v[1]), cvt_pk_bf16(v[2], v[3])}; } } }
    }
};
#define PG2_TR(dst, a, off) asm volatile("ds_read_b64_tr_b16 %0, %1 offset:%2" : "=&v"(dst) : "v"(a), "i"(off) : "memory")
template <class Epi, class Sched, class BF, bool GATHER>
__device__ __forceinline__ void gemm2_phase(LAS unsigned char* lds, const bf16* A, int K, const Sched& S, const BF& bfn, const Epi& E, const LAS unsigned* rowoff) {
    const int tid = threadIdx.x, wid = __builtin_amdgcn_readfirstlane(tid >> 6), lane = tid & 63, wr = wid >> 1, wc = wid & 1, fr = lane & 15, fq = lane >> 4;
    const int nt = K / 64;
    int gR[2], gC[2];
#pragma unroll
    for (int i = 0; i < 2; ++i) stage_rc(tid * 16 + i * 8192, gR[i], gC[i]);
    const unsigned ldsw = (unsigned)wid * 1024u;
    const int aoff = (wr >> 1) * HTB + lds_byte((wr & 1) * 64 + fr, fq * 8);
    const int c4 = tid & 31, kr = tid >> 5;
    const int bwr = BOFF + (8 * ((kr >> 2) & 1) + 4 * (kr >> 3) + (kr & 3)) * PB + 8 * c4;
    const int brd = (int)(uintptr_t)lds + BOFF + (16 * (fq >> 1) + 4 * (fq & 1) + ((lane & 15) >> 2)) * PB + (64 * wc + 4 * (lane & 3)) * 2;
    Unit2 u, un;
    int jn = 0;
    if constexpr (Sched::DYNAMIC) {
        if (tid == 0) { const int j0 = (int)S.grab(), j1 = (int)S.grab(); S.slot[0] = j0; S.slot[1] = j1; }
        __syncthreads();
        const int j0 = S.slot[0]; jn = S.slot[1];
        __syncthreads();
        if (!S.decode(j0, u)) return;
    } else { if (!S.next(0, u)) return; }
    unsigned o00, o01, o10, o11, p00, p01, p10, p11;
    const char* cA; const char* nA; const float* bp; const float* nbp; int ldb;
#define PG2_SETUP(U, UI, cA_, q00, q01, q10, q11, bp_) do { \
        if constexpr (GATHER) { const LAS unsigned* r_ = rowoff + (UI) * 256; cA_ = (const char*)A; \
            q00 = r_[gR[0]] + gC[0] * 2; q01 = r_[gR[1]] + gC[1] * 2; q10 = r_[128 + gR[0]] + gC[0] * 2; q11 = r_[128 + gR[1]] + gC[1] * 2; } \
        else { cA_ = (const char*)A + (size_t)(U).pm * 256 * K * 2; q00 = (unsigned)(gR[0] * K + gC[0]) * 2u; q01 = (unsigned)(gR[1] * K + gC[1]) * 2u; q10 = q00 + (unsigned)(128 * K * 2); q11 = q01 + (unsigned)(128 * K * 2); } \
        bp_ = bfn((U).e, (U).pn, c4, ldb) + (size_t)kr * ldb; } while (0)
#define PG2_STAGE_AH(buf, tau, h) do { const bool nx_ = (tau) >= nt; const char* g_ = (nx_ ? nA + (size_t)((tau) - nt) * 128 : cA + (size_t)(tau) * 128); \
        const unsigned q0_ = (h) ? (nx_ ? p10 : o10) : (nx_ ? p00 : o00), q1_ = (h) ? (nx_ ? p11 : o11) : (nx_ ? p01 : o01); \
        __builtin_amdgcn_global_load_lds((const unsigned*)(g_ + q0_), (LAS unsigned*)(lds + ((buf) * 2 + (h)) * HTB + ldsw), 16, 0, 0); \
        __builtin_amdgcn_global_load_lds((const unsigned*)(g_ + q1_), (LAS unsigned*)(lds + ((buf) * 2 + (h)) * HTB + ldsw + 8192), 16, 0, 0); } while (0)
#define PG2_LOAD_BH(breg, tau, i0) do { const float* b_ = (tau) >= nt ? nbp + (size_t)(((tau) - nt) * 64) * ldb : bp + (size_t)((tau) * 64) * ldb; \
        _Pragma("unroll") for (int i = (i0); i < (i0) + 2; ++i) { const float* p_ = b_ + (size_t)(16 * i) * ldb; \
        asm volatile("global_load_dwordx4 %0, %1, off" : "=&v"(breg[i]) : "v"(p_) : "memory"); } } while (0)
#define PG2_WRITE_B(breg, buf) do { _Pragma("unroll") for (int i = 0; i < 4; ++i) *(LAS v2u*)(lds + bwr + (buf) * BBUF + (32 * (i >> 1) + 16 * (i & 1)) * PB) = (v2u){cvt_pk_bf16(breg[i].x, breg[i].y), cvt_pk_bf16(breg[i].z, breg[i].w)}; } while (0)
#define PG2_FR(ks, af, l0, h0, l1, h1, l2, h2, l3, h3) do { \
            _Pragma("unroll") for (int m = 0; m < 4; ++m) af[m] = *(const LAS bf16x8*)(lds + ab + m * 2048 + (ks) * 1024); \
            PG2_TR(l0, bb, (ks) * 32 * PB + 0); PG2_TR(h0, bb, (ks) * 32 * PB + 0 + 8 * PB); PG2_TR(l1, bb, (ks) * 32 * PB + 32); PG2_TR(h1, bb, (ks) * 32 * PB + 32 + 8 * PB); \
            PG2_TR(l2, bb, (ks) * 32 * PB + 64); PG2_TR(h2, bb, (ks) * 32 * PB + 64 + 8 * PB); PG2_TR(l3, bb, (ks) * 32 * PB + 96); PG2_TR(h3, bb, (ks) * 32 * PB + 96 + 8 * PB); } while (0)
#define PG2_MMH(af, m0, l0, h0, l1, h1, l2, h2, l3, h3) do { \
            const bf16x8 b0 = {l0[0], l0[1], l0[2], l0[3], h0[0], h0[1], h0[2], h0[3]}, b1 = {l1[0], l1[1], l1[2], l1[3], h1[0], h1[1], h1[2], h1[3]}, \
                         b2 = {l2[0], l2[1], l2[2], l2[3], h2[0], h2[1], h2[2], h2[3]}, b3 = {l3[0], l3[1], l3[2], l3[3], h3[0], h3[1], h3[2], h3[3]}; \
            __builtin_amdgcn_s_setprio(1); \
            _Pragma("unroll") for (int m = (m0); m < (m0) + 2; ++m) { acc[m][0] = __builtin_amdgcn_mfma_f32_16x16x32_bf16(b0, af[m], acc[m][0], 0, 0, 0); acc[m][1] = __builtin_amdgcn_mfma_f32_16x16x32_bf16(b1, af[m], acc[m][1], 0, 0, 0); \
                acc[m][2] = __builtin_amdgcn_mfma_f32_16x16x32_bf16(b2, af[m], acc[m][2], 0, 0, 0); acc[m][3] = __builtin_amdgcn_mfma_f32_16x16x32_bf16(b3, af[m], acc[m][3], 0, 0, 0); } \
            __builtin_amdgcn_s_setprio(0); __builtin_amdgcn_sched_barrier(0); } while (0)
#define PG2_ITER(t_, b_, brn, brw) do { \
            const int ab = aoff + a0 * (2 * HTB), bb = brd + (b_) * BBUF; \
            const bool n1_ = ((t_) + 1 < nt) || has_next, n2_ = ((t_) + 2 < nt) || has_next; \
            bf16x8 afa[4], afb[4]; s16x4 al0, ah0, al1, ah1, al2, ah2, al3, ah3, bl0, bh0, bl1, bh1, bl2, bh2, bl3, bh3; \
            PG2_FR(0, afa, al0, ah0, al1, ah1, al2, ah2, al3, ah3); \
            if (n2_) PG2_STAGE_AH(a2, (t_) + 2, 0); \
            asm volatile("s_waitcnt lgkmcnt(0)" ::: "memory"); __builtin_amdgcn_sched_barrier(0); \
            PG2_FR(1, afb, bl0, bh0, bl1, bh1, bl2, bh2, bl3, bh3); \
            PG2_MMH(afa, 0, al0, ah0, al1, ah1, al2, ah2, al3, ah3); \
            if (n2_) PG2_STAGE_AH(a2, (t_) + 2, 1); \
            __builtin_amdgcn_sched_barrier(0); \
            PG2_MMH(afa, 2, al0, ah0, al1, ah1, al2, ah2, al3, ah3); \
            if (n2_) PG2_LOAD_BH(brw, (t_) + 2, 0); \
            asm volatile("s_waitcnt lgkmcnt(0)" ::: "memory"); __builtin_amdgcn_sched_barrier(0); \
            PG2_MMH(afb, 0, bl0, bh0, bl1, bh1, bl2, bh2, bl3, bh3); \
            if (n2_) PG2_LOAD_BH(brw, (t_) + 2, 2); \
            __builtin_amdgcn_sched_barrier(0); \
            PG2_MMH(afb, 2, bl0, bh0, bl1, bh1, bl2, bh2, bl3, bh3); \
            if (n1_) { if (n2_) asm volatile("s_waitcnt vmcnt(8)" ::: "memory"); else asm volatile("s_waitcnt vmcnt(0)" ::: "memory");     \
                       PG2_WRITE_B(brn, (b_) ^ 1); } \
            asm volatile("s_waitcnt lgkmcnt(0)" ::: "memory"); \
            __builtin_amdgcn_s_barrier(); asm volatile("" ::: "memory");                     \
            { const int r_ = a0; a0 = a1; a1 = a2; a2 = r_; } } while (0)
    if (wid == 0) S.wait_tile(u.pm);
    __builtin_amdgcn_s_barrier(); asm volatile("" ::: "memory");
    PG2_SETUP(u, 0, cA, o00, o01, o10, o11, bp);
    nA = cA; nbp = bp; p00 = o00; p01 = o01; p10 = o10; p11 = o11;
    f32x4 br0[4], br1[4];
    int a0 = 0, a1 = 1, a2 = 2;
    { const bool has_next = false; (void)has_next;
      PG2_STAGE_AH(0, 0, 0); PG2_STAGE_AH(0, 0, 1); PG2_LOAD_BH(br0, 0, 0); PG2_LOAD_BH(br0, 0, 2);
      PG2_STAGE_AH(1, 1, 0); PG2_STAGE_AH(1, 1, 1); PG2_LOAD_BH(br1, 1, 0); PG2_LOAD_BH(br1, 1, 2);
      asm volatile("s_waitcnt vmcnt(8)" ::: "memory");
      PG2_WRITE_B(br0, 0);
      asm volatile("s_waitcnt lgkmcnt(0)" ::: "memory");
      __builtin_amdgcn_s_barrier(); asm volatile("" ::: "memory"); }
#pragma unroll 1
    for (int ui = 0;; ++ui) {
        bool has_next;
        if constexpr (Sched::DYNAMIC) has_next = S.decode(jn, un); else has_next = S.next(ui + 1, un);
        if (has_next) PG2_SETUP(un, ui + 1, nA, p00, p01, p10, p11, nbp);
        if constexpr (Sched::DYNAMIC) {
            if (has_next && wid == 0) { unsigned vq = 0u; if (lane == 0) vq = S.grab();
                S.wait_tile(un.pm);
                if (lane == 0) S.slot[ui & 1] = (int)vq; }
        } else { if (has_next && wid == 0) S.wait_tile(un.pm); }
        f32x4 acc[4][4];
#pragma unroll
        for (int m = 0; m < 4; ++m)
#pragma unroll
            for (int n = 0; n < 4; ++n) acc[m][n] = (f32x4){0.f, 0.f, 0.f, 0.f};
#pragma unroll 1
        for (int t = 0; t < nt; t += 2) {
            PG2_ITER(t, 0, br1, br0);
            PG2_ITER(t + 1, 1, br0, br1);
        }
        E(acc, u, wr, wc, fr, fq);
        if (!has_next) break;
        u = un; cA = nA; bp = nbp; o00 = p00; o01 = p01; o10 = p10; o11 = p11;
        if constexpr (Sched::DYNAMIC) jn = S.slot[ui & 1];
    }
#undef PG2_SETUP
#undef PG2_STAGE_AH
#undef PG2_LOAD_BH
#undef PG2_WRITE_B
#undef PG2_FR
#undef PG2_MMH
#undef PG2_ITER
}
}

namespace pg3 {
using pg8::lds_byte; using pg8::stage_rc; using pg8::cvt_pk_bf16; using pg2::Unit2; using pg2::s16x4;
constexpr int HTB = 16384, PB = 544, BBUF = 64 * PB, BOFF = 4 * HTB;
struct GateUpB { const float* wg; const float* wu; __device__ __forceinline__ const float* operator()(int e, int pn, int c4, int& ldb) const { ldb = FF_; const int blk = c4 >> 2;
    const long long dlt = (const char*)wu - (const char*)wg;
    return (const float*)((const char*)wg + ((blk & 1) ? dlt : 0ll)) + (size_t)e * D_MODEL_ * FF_ + 128 * pn + 16 * (blk >> 1) + 4 * (c4 & 3); } };
struct EpiGateUp3 {
    bf16* O; int ldc; unsigned* tile_cnt;
    __device__ __forceinline__ void operator()(const f32x4 (&acc)[4][8], const Unit2& u, int wr, int wc, int fr, int fq) const {
#pragma unroll
        for (int m = 0; m < 4; ++m) { bf16* rowp = O + (size_t)(u.pm * 256 + wr * 64 + m * 16 + fr) * ldc + u.pn * 128 + 64 * wc + 4 * fq;
#pragma unroll
            for (int j = 0; j < 4; ++j) { float r[4];
#pragma unroll
                for (int i = 0; i < 4; ++i) { const float g = acc[m][2 * j][i], up = acc[m][2 * j + 1][i]; r[i] = g * __builtin_amdgcn_rcpf(1.0f + __builtin_amdgcn_exp2f(-1.4426950408889634f * g)) * up; }
                const unsigned long long pk = (unsigned long long)cvt_pk_bf16(r[0], r[1]) | ((unsigned long long)cvt_pk_bf16(r[2], r[3]) << 32);
                __hip_atomic_store((unsigned long long*)(rowp + 16 * j), pk, __ATOMIC_RELAXED, __HIP_MEMORY_SCOPE_AGENT); } }
    }
    static constexpr bool DEFER = true;
    __device__ __forceinline__ void publish(int pm) const { if ((threadIdx.x & 63) == 0) __hip_atomic_fetch_add(tile_cnt + 16 * pm, 1u, __ATOMIC_RELAXED, __HIP_MEMORY_SCOPE_AGENT); }
};
struct DownB3 { const float* w; __device__ __forceinline__ const float* operator()(int e, int pn, int c4, int& ldb) const { ldb = D_MODEL_; return w + (size_t)e * FF_ * D_MODEL_ + 256 * pn + 4 * c4; } };
struct EpiDown3 {
    static constexpr bool DEFER = false; __device__ __forceinline__ void publish(int) const {}
    bf16* Y; int ldc; int T; const int* row_tok; const float* row_gate; const LAS int* pstart; const LAS int* lcnt;
    __device__ __forceinline__ void operator()(const f32x4 (&acc)[4][8], const Unit2& u, int wr, int wc, int fr, int fq) const {
        const int s0 = (u.pm - (pstart[u.e] >> 8)) * 256 + wr * 64 + fr, cnt = lcnt[u.e]; const size_t lb = (size_t)u.e * ECAP_;
#pragma unroll
        for (int m = 0; m < 4; ++m) { const int s_ = s0 + m * 16; const bool ok = s_ < cnt; const int rt0 = row_tok[lb + (ok ? s_ : 0)]; const float gt = row_gate[lb + (ok ? s_ : 0)]; const int rt = ok ? rt0 : -1;
            if (rt >= 0) { bf16* rowp = Y + ((size_t)(rt & 1) * T + (size_t)(rt >> 1)) * ldc + u.pn * 256 + wc * 128 + 4 * fq;
#pragma unroll
                for (int n = 0; n < 8; ++n) { const f32x4 v = acc[m][n] * gt; *(v2u*)(rowp + 16 * n) = (v2u){cvt_pk_bf16(v[0], v[1]), cvt_pk_bf16(v[2], v[3])}; } } }
    }
};
template <class Epi, class Sched, class BF, bool GATHER>
__device__ __forceinline__ void gemm3_phase(LAS unsigned char* lds, const bf16* A, int K, const Sched& S, const BF& bfn, const Epi& E, const LAS unsigned* rowoff) {
    const int tid = threadIdx.x, wid = __builtin_amdgcn_readfirstlane(tid >> 6), lane = tid & 63, wr = wid >> 1, wc = wid & 1, fr = lane & 15, fq = lane >> 4;
    const int nt = K / 64;
    int gR[2], gC[2];
#pragma unroll
    for (int i = 0; i < 2; ++i) stage_rc(tid * 16 + i * 8192, gR[i], gC[i]);
    const unsigned ldsw = (unsigned)wid * 1024u;
    const int aoff = (wr >> 1) * HTB + lds_byte((wr & 1) * 64 + fr, fq * 8);
    const int c4 = tid & 63, kr = tid >> 6;
    const int bwr = BOFF + (8 * (kr >> 2) + (kr & 3)) * PB + 8 * c4;
    const int brd = (int)(uintptr_t)lds + BOFF + (16 * (fq >> 1) + 4 * (fq & 1) + ((lane & 15) >> 2)) * PB + (128 * wc + 4 * (lane & 3)) * 2;
    int pend = -1;
    Unit2 u;
    int jc = 0, jn = 0;
    if constexpr (Sched::DYNAMIC) {
        if (tid == 0) { const int j0 = (int)S.grab(), j1 = (int)S.grab(); S.slot[0] = j0; S.slot[1] = j1; }
        __syncthreads();
        jc = __builtin_amdgcn_readfirstlane(S.slot[0]); jn = __builtin_amdgcn_readfirstlane(S.slot[1]);
        __syncthreads();
    }
#pragma unroll 1
    for (int ui = 0;; ++ui) {
        bool have;
        if constexpr (Sched::DYNAMIC) have = __builtin_amdgcn_readfirstlane((int)S.decode(jc, u)) != 0; else have = __builtin_amdgcn_readfirstlane((int)S.next(ui, u)) != 0;
        if (!have) break;
        u.pm = __builtin_amdgcn_readfirstlane(u.pm); u.pn = __builtin_amdgcn_readfirstlane(u.pn); u.e = __builtin_amdgcn_readfirstlane(u.e);
        if constexpr (Sched::DYNAMIC) {
            if (wid == 0) { unsigned vq = 0u; if (lane == 0) vq = S.grab();
                S.wait_tile(u.pm);
                if (lane == 0) S.slot[ui & 1] = (int)vq; }
            __builtin_amdgcn_s_barrier(); asm volatile("" ::: "memory"); }
        f32x4 acc[4][8];
#pragma unroll
        for (int m = 0; m < 4; ++m)
#pragma unroll
            for (int n = 0; n < 8; ++n) acc[m][n] = (f32x4){0.f, 0.f, 0.f, 0.f};
        const char* cA; unsigned o00, o01, o10, o11;
        if constexpr (GATHER) { const LAS unsigned* r_ = rowoff + ui * 256; cA = (const char*)A;
            o00 = r_[gR[0]] + gC[0] * 2; o01 = r_[gR[1]] + gC[1] * 2; o10 = r_[128 + gR[0]] + gC[0] * 2; o11 = r_[128 + gR[1]] + gC[1] * 2; }
        else { cA = (const char*)A + (size_t)u.pm * 256 * K * 2; o00 = (unsigned)(gR[0] * K + gC[0]) * 2u; o01 = (unsigned)(gR[1] * K + gC[1]) * 2u; o10 = o00 + (unsigned)(128 * K * 2); o11 = o01 + (unsigned)(128 * K * 2); }
        int ldb; const float* bp = bfn(u.e, u.pn, c4, ldb) + (size_t)kr * ldb;
#define PG3_STAGE_A(buf, kt) do { const char* g_ = cA + (size_t)(kt) * 128; \
        __builtin_amdgcn_global_load_lds((const unsigned*)(g_ + o00), (LAS unsigned*)(lds + ((buf) * 2 + 0) * HTB + ldsw), 16, 0, 0); \
        __builtin_amdgcn_global_load_lds((const unsigned*)(g_ + o01), (LAS unsigned*)(lds + ((buf) * 2 + 0) * HTB + ldsw + 8192), 16, 0, 0); \
        __builtin_amdgcn_global_load_lds((const unsigned*)(g_ + o10), (LAS unsigned*)(lds + ((buf) * 2 + 1) * HTB + ldsw), 16, 0, 0); \
        __builtin_amdgcn_global_load_lds((const unsigned*)(g_ + o11), (LAS unsigned*)(lds + ((buf) * 2 + 1) * HTB + ldsw + 8192), 16, 0, 0); } while (0)
#define PG3_LOAD_B(kt) do { _Pragma("unroll") for (int i = 0; i < 8; ++i) { const float* p_ = bp + (size_t)((kt) * 64 + 8 * i) * ldb; \
        asm volatile("global_load_dwordx4 %0, %1, off" : "=&v"(breg[i]) : "v"(p_) : "memory"); } } while (0)
#define PG3_WRITE_B(buf) do { _Pragma("unroll") for (int i = 0; i < 8; ++i) *(LAS v2u*)(lds + bwr + (buf) * BBUF + (32 * (i >> 2) + 16 * ((i >> 1) & 1) + 4 * (i & 1)) * PB) = (v2u){cvt_pk_bf16(breg[i].x, breg[i].y), cvt_pk_bf16(breg[i].z, breg[i].w)}; } while (0)
        f32x4 breg[8];
        PG3_LOAD_B(0); PG3_STAGE_A(0, 0);
        asm volatile("s_waitcnt vmcnt(0)" ::: "memory");
        if constexpr (Epi::DEFER) { if (pend >= 0) { E.publish(pend); pend = -1; } }
        PG3_WRITE_B(0);
        PG3_LOAD_B(1);
        asm volatile("s_waitcnt lgkmcnt(0)" ::: "memory"); __builtin_amdgcn_s_barrier(); asm volatile("" ::: "memory");
#define PG3_TRP(l_, h_, n_, ks_) PG2_TR(l_, bb, (ks_) * 32 * PB + (n_) * 32); PG2_TR(h_, bb, (ks_) * 32 * PB + (n_) * 32 + 8 * PB)
#define PG3_BF(l_, h_) ((bf16x8){l_[0], l_[1], l_[2], l_[3], h_[0], h_[1], h_[2], h_[3]})
#define PG3_KS(ks) do { bf16x8 af[4]; s16x4 l0, h0, l1, h1, l2, h2, l3, h3, l4, h4, l5, h5, l6, h6, l7, h7; \
            _Pragma("unroll") for (int m = 0; m < 4; ++m) af[m] = *(const LAS bf16x8*)(lds + ab + m * 2048 + (ks) * 1024); \
            PG3_TRP(l0, h0, 0, ks); PG3_TRP(l1, h1, 1, ks); PG3_TRP(l2, h2, 2, ks); PG3_TRP(l3, h3, 3, ks); PG3_TRP(l4, h4, 4, ks); PG3_TRP(l5, h5, 5, ks); PG3_TRP(l6, h6, 6, ks); PG3_TRP(l7, h7, 7, ks); \
            asm volatile("s_waitcnt lgkmcnt(0)" ::: "memory"); __builtin_amdgcn_sched_barrier(0); \
            const bf16x8 b0 = PG3_BF(l0, h0), b1 = PG3_BF(l1, h1), b2 = PG3_BF(l2, h2), b3 = PG3_BF(l3, h3), b4 = PG3_BF(l4, h4), b5 = PG3_BF(l5, h5), b6 = PG3_BF(l6, h6), b7 = PG3_BF(l7, h7); \
            __builtin_amdgcn_s_setprio(1); \
            _Pragma("unroll") for (int m = 0; m < 4; ++m) { \
                acc[m][0] = __builtin_amdgcn_mfma_f32_16x16x32_bf16(b0, af[m], acc[m][0], 0, 0, 0); acc[m][1] = __builtin_amdgcn_mfma_f32_16x16x32_bf16(b1, af[m], acc[m][1], 0, 0, 0); \
                acc[m][2] = __builtin_amdgcn_mfma_f32_16x16x32_bf16(b2, af[m], acc[m][2], 0, 0, 0); acc[m][3] = __builtin_amdgcn_mfma_f32_16x16x32_bf16(b3, af[m], acc[m][3], 0, 0, 0); \
                acc[m][4] = __builtin_amdgcn_mfma_f32_16x16x32_bf16(b4, af[m], acc[m][4], 0, 0, 0); acc[m][5] = __builtin_amdgcn_mfma_f32_16x16x32_bf16(b5, af[m], acc[m][5], 0, 0, 0); \
                acc[m][6] = __builtin_amdgcn_mfma_f32_16x16x32_bf16(b6, af[m], acc[m][6], 0, 0, 0); acc[m][7] = __builtin_amdgcn_mfma_f32_16x16x32_bf16(b7, af[m], acc[m][7], 0, 0, 0); } \
            __builtin_amdgcn_s_setprio(0); } while (0)
#pragma unroll 1
        for (int t = 0; t < nt; ++t) {
            const int b = t & 1;
            if (t + 1 < nt) PG3_STAGE_A(b ^ 1, t + 1);
            const int ab = aoff + b * 2 * HTB, bb = brd + b * BBUF;
            PG3_KS(0);
            if (t + 1 < nt) {
                asm volatile("s_waitcnt vmcnt(4)" ::: "memory");
                PG3_WRITE_B(b ^ 1);
                if (t + 2 < nt) PG3_LOAD_B(t + 2);
            }
            PG3_KS(1);
            if (t + 1 < nt) { if (t + 2 < nt) asm volatile("s_waitcnt vmcnt(8)" ::: "memory"); else asm volatile("s_waitcnt vmcnt(0)" ::: "memory"); }
            asm volatile("s_waitcnt lgkmcnt(0)" ::: "memory"); __builtin_amdgcn_s_barrier(); asm volatile("" ::: "memory");
        }
        E(acc, u, wr, wc, fr, fq);
        if constexpr (Epi::DEFER) pend = u.pm;
        if constexpr (Sched::DYNAMIC) { jc = jn; jn = __builtin_amdgcn_readfirstlane(S.slot[ui & 1]); }
#undef PG3_STAGE_A
#undef PG3_LOAD_B
#undef PG3_WRITE_B
#undef PG3_TRP
#undef PG3_BF
#undef PG3_KS
    }
    if constexpr (Epi::DEFER) { if (pend >= 0) { asm volatile("s_waitcnt vmcnt(0)" ::: "memory"); E.publish(pend); } }
}
}

constexpr int NWAVES = 8;
constexpr int D = 4096, NB = 4, SEQ = 2048, T = NB * SEQ;
constexpr int AW = 2048, NH = 16, HD = 128;
constexpr int SW = 2048, SH = 32, SP = 64, SG = 8, SN = 128;
constexpr int NPROJ = 12288, NPROJ_ALL = 12320;
constexpr int Q0 = 0, K0 = 2048, V0 = 4096, Z0 = 6144, XBC0 = 8192;
constexpr int NE = 32, EPG = 8, NGRP = 4, FF = 1024;
constexpr int ECAP = T;
constexpr int MAXMT = 96;
constexpr float NORM_EPS = 1e-6f, SSD_NORM_EPS = 1e-5f;

constexpr size_t al256(size_t x) { return (x + 255) & ~(size_t)255; }
constexpr size_t WS_CTL = 0, CTL_ZERO_BYTES = 1u << 20;
constexpr size_t WS_WIN = CTL_ZERO_BYTES;
constexpr size_t WS_WOUT = WS_WIN + al256((size_t)NPROJ_ALL * D * 2);
constexpr size_t WS_WGU = WS_WOUT + (size_t)D * D * 2;
constexpr size_t WS_WD = WS_WGU + (size_t)NE * 2 * FF * D * 2;
constexpr size_t WS_H = WS_WD + (size_t)NE * D * FF * 2;
constexpr size_t WS_PROJ = WS_H + (size_t)T * D * 2;
constexpr size_t WS_QN = WS_PROJ + (size_t)T * NPROJ * 2;
constexpr size_t WS_KN = WS_QN + (size_t)T * AW * 2;
constexpr size_t WS_XC = WS_KN + (size_t)T * AW * 2;
constexpr size_t WS_DT = WS_XC + (size_t)T * 4096 * 2;
constexpr size_t WS_DA = WS_DT + (size_t)T * SH * 4;
constexpr size_t WS_YG = WS_DA + (size_t)T * SH * 4;
constexpr size_t WS_MIX = WS_YG + (size_t)T * SW * 4;
constexpr size_t WS_ACT = WS_MIX + (size_t)T * D * 2;
constexpr size_t WS_YS = WS_ACT + (size_t)MAXMT * 256 * FF * 2;
constexpr size_t WS_TOK = WS_YS + (size_t)2 * T * D * 2;
constexpr size_t WS_ROW = WS_TOK + (size_t)3 * T * 2 * 4;
constexpr size_t WS_OBR = WS_ROW + (size_t)2 * MAXMT * 256 * 4;
constexpr size_t WS_ML = WS_OBR + (size_t)3 * T * AW * 2;
constexpr size_t WS_ST = WS_ML + (size_t)3 * T * NH * 8;
constexpr size_t WS_CT = WS_ST + (size_t)NB * 8 * SH * SP * SN * 4;
constexpr size_t WS_RW = WS_CT + 4096;
constexpr size_t WS_END = WS_RW + (size_t)D * 48 * 4;
static_assert((size_t)MAXMT * 256 * D * 2 <= (size_t)T * NPROJ * 2, "Xg overlays PROJ");
constexpr int CW_CNT = 64;
constexpr int CW_BAR = 4096;
constexpr int CW_DQ = 12288;
constexpr int CW_TILE = 8192;

constexpr int RING_OFF = 0, RING_BYTES = 135168;
constexpr int LDSCTL_OFF = RING_BYTES;
constexpr int L_MISC = LDSCTL_OFF;
constexpr int L_TILE_E = LDSCTL_OFF + 256;
constexpr int L_PSTART = LDSCTL_OFF + 256 + 512;
constexpr int L_CNT = LDSCTL_OFF + 256 + 512 + 256;
constexpr int L_XE = LDSCTL_OFF + 1280;
constexpr int L_ATT = LDSCTL_OFF + 2048;
constexpr int L_SSD = LDSCTL_OFF + 4096;
constexpr int LDS_BYTES = 151552;
static_assert(L_CNT + 128 <= L_ATT && L_ATT + 2048 <= L_SSD && L_SSD + 8192 + 128 <= LDS_BYTES, "LDS map");

#define XB_TMO      128
#define XB_XCNT(j)  (256  + 64 * (j))
#define XB_XSUB(j)  (1280 + 64 * (j))
#define XB_XGEN(j)  (2304 + 64 * (j))
#define XB_TOP      3328
#define XB_TOPGEN   3392
#define XCD_BAR_WORDS 3456
#define XB_SPIN_CAP (1u << 20)
__device__ __forceinline__ unsigned xb_ld(unsigned* p)              { return __hip_atomic_load(p, __ATOMIC_RELAXED, __HIP_MEMORY_SCOPE_AGENT); }
__device__ __forceinline__ unsigned xb_add(unsigned* p, unsigned v) { return __hip_atomic_fetch_add(p, v, __ATOMIC_RELAXED, __HIP_MEMORY_SCOPE_AGENT); }
__device__ __forceinline__ unsigned xb_xcc_id() { return (unsigned)__builtin_amdgcn_s_getreg((3 << 11) | 20) & 0xFu; }
#define XB_SPIN(cond, bar) do { unsigned _sp = 0; while (cond) { __builtin_amdgcn_s_sleep(1); \
    if ((++_sp & 255u) == 0u) { if (xb_ld(&(bar)[XB_TMO])) break; if (_sp > XB_SPIN_CAP) { atomicAdd(&(bar)[XB_TMO], 1u); break; } } } } while (0)
struct XcdBarrier { unsigned* bar; unsigned x; volatile LAS unsigned* st; };
__device__ __forceinline__ XcdBarrier xcd_barrier_post(unsigned* bar, volatile LAS unsigned* st) {
    XcdBarrier b; b.bar = bar; b.x = xb_xcc_id(); b.st = st;
    if (threadIdx.x == 0) (void)xb_add(&bar[XB_XCNT(b.x)], 1u);
    return b;
}
__device__ __forceinline__ void xcd_barrier_complete(unsigned* bar, unsigned x, unsigned& nloc, unsigned& nx) {
    const unsigned G = gridDim.x * gridDim.y * gridDim.z;
    unsigned sum, cnt, mine, sp = 0u;
    for (;;) {
        sum = 0u; cnt = 0u; mine = 0u;
#pragma unroll
        for (unsigned j = 0; j < 16; ++j) { const unsigned c = xb_ld(&bar[XB_XCNT(j)]); sum += c; cnt += (c > 0u) ? 1u : 0u; mine = (j == x) ? c : mine; }
        if (sum == G) break;
        __builtin_amdgcn_s_sleep(1);
        if ((++sp & 255u) == 0u) { if (xb_ld(&bar[XB_TMO])) break; if (sp > XB_SPIN_CAP) { atomicAdd(&bar[XB_TMO], 1u); break; } }
    }
    nloc = mine > 0u ? mine : 1u; nx = cnt > 0u ? cnt : 1u;
}
__device__ __forceinline__ void xcd_barrier(const XcdBarrier& b) {
    asm volatile("s_waitcnt vmcnt(0)" ::: "memory");
    __syncthreads();
    if (threadIdx.x == 0) {
        unsigned* bar = b.bar;
        __builtin_amdgcn_s_waitcnt(0);
        unsigned nloc = b.st[0], nx = b.st[1];
        if (nloc == 0u) { xcd_barrier_complete(bar, b.x, nloc, nx); b.st[0] = nloc; b.st[1] = nx; }
        const unsigned old = xb_add(&bar[XB_XSUB(b.x)], 1u);
        const unsigned gen = old / nloc;
        if (old + 1u == (gen + 1u) * nloc) {
            __builtin_amdgcn_fence(__ATOMIC_RELEASE, "agent");
            asm volatile("s_waitcnt vmcnt(0)" ::: "memory");
            const unsigned og = xb_add(&bar[XB_TOP], 1u);
            const unsigned tg = og / nx;
            if (og + 1u == (tg + 1u) * nx) xb_add(&bar[XB_TOPGEN], 1u);
            else XB_SPIN(xb_ld(&bar[XB_TOPGEN]) == tg, bar);
            __builtin_amdgcn_fence(__ATOMIC_ACQUIRE, "agent");
            xb_add(&bar[XB_XGEN(b.x)], 1u);
            asm volatile("s_waitcnt vmcnt(0)" ::: "memory");
        } else {
            XB_SPIN(xb_ld(&bar[XB_XGEN(b.x)]) == gen, bar);
            __builtin_amdgcn_fence(__ATOMIC_ACQUIRE, "agent");
            asm volatile("s_waitcnt vmcnt(0)" ::: "memory");
        }
    }
    __syncthreads();
}

struct Args { const void* in[21]; float* out; unsigned char* ws; int ph_lo, ph_hi; };
struct Frame {
    LAS unsigned char* lds;
    unsigned* ctl;
    int tid, lane, wave, G, bx;
    const float *x; const int* pos; const float *norm_attn_w, *w_in, *q_norm_w, *k_norm_w, *conv_w, *conv_b, *dt_bias, *a_log, *d_skip, *ssd_norm_w, *w_out, *norm_ffn_w,
        *rg_w, *rg_b, *re_w, *re_b, *w_gate, *w_up, *w_down;
    float* out;
    bf16 *WinT, *WoT, *WguT, *WdT, *Hb, *PROJ, *QN, *KN, *XC, *MIX, *ACT, *YS, *XG;
    float *DT, *DA, *YG; bf16* OBR; float* ML; float *ST, *CT, *RW; bf16* X1B;
    int *tok_e, *tok_slot; float* tok_gate; int* row_tok; float* row_gate;
};

#define PIN_FRAME(F) Frame F = F0; asm volatile("" : "+v"(F.lane), "+v"(F.tid))
__device__ __forceinline__ void transpose_item(const float* W, int N, bf16* dst, int Kd, int k0, int n0, LAS float* scr, int lane) {
    const float* src = W + (size_t)(k0 + (lane >> 5)) * N + n0 + (lane & 31);
    float v[32];
#pragma unroll
    for (int i = 0; i < 32; ++i) v[i] = __builtin_nontemporal_load(src + (size_t)(2 * i) * N);
#pragma unroll
    for (int i = 0; i < 32; ++i) scr[(2 * i + (lane >> 5)) * 33 + (lane & 31)] = v[i];
    LDS_WAIT(); asm volatile("" ::: "memory");
    const int c = lane & 7;
#pragma unroll
    for (int j = 0; j < 4; ++j) { const int n = (lane >> 3) + 8 * j; const LAS float* s = scr + (8 * c) * 33 + n;
        v4u o; o.x = pk2(s[0 * 33], s[1 * 33]); o.y = pk2(s[2 * 33], s[3 * 33]); o.z = pk2(s[4 * 33], s[5 * 33]); o.w = pk2(s[6 * 33], s[7 * 33]);
        *(v4u*)(dst + (size_t)n * Kd + k0 + 8 * c) = o; }
    LDS_WAIT(); asm volatile("" ::: "memory");
}
__device__ __forceinline__ void rms_row_to_bf16(const float* xrow, const float* nw, bf16* orow, int lane) {
    const f32x4* xr = (const f32x4*)xrow + lane; const f32x4* wr = (const f32x4*)nw + lane;
    f32x4 v[16]; float s = 0.f;
#pragma unroll
    for (int j = 0; j < 16; ++j) { v[j] = xr[64 * j]; s += (v[j].x * v[j].x + v[j].y * v[j].y) + (v[j].z * v[j].z + v[j].w * v[j].w); }
    const float rstd = 1.0f / sqrtf(wave_sum(s) * (1.f / D) + NORM_EPS);
    unsigned long long* o8 = (unsigned long long*)orow + lane;
#pragma unroll
    for (int j = 0; j < 16; ++j) { const f32x4 w = wr[64 * j]; o8[64 * j] = (unsigned long long)pk2(v[j].x * rstd * w.x, v[j].y * rstd * w.y) | ((unsigned long long)pk2(v[j].z * rstd * w.z, v[j].w * rstd * w.w) << 32); }
}
struct TI { const float* src; bf16* dst; int N, Kd; };
__device__ __forceinline__ void t_issue(const TI& t, int lane, f32x4 (&v)[16]) {
    const f32x4* p = (const f32x4*)(t.src + (size_t)(lane >> 4) * t.N + 4 * (lane & 15));
#pragma unroll
    for (int i = 0; i < 16; ++i) v[i] = __builtin_nontemporal_load((const f32x4*)((const float*)p + (size_t)(4 * i) * t.N));
}
__device__ __forceinline__ void t_finish(const TI& t, int lane, const f32x4 (&v)[16], LAS float* scr) {
    const int c = lane & 7, kr = lane >> 4, c4 = lane & 15;
#pragma unroll
    for (int hf = 0; hf < 2; ++hf) {
        if ((c4 >> 3) == hf) {
#pragma unroll
            for (int i = 0; i < 16; ++i) { LAS float* q = scr + (4 * i + kr) * 33 + 4 * (c4 & 7); q[0] = v[i].x; q[1] = v[i].y; q[2] = v[i].z; q[3] = v[i].w; }
        }
        LDS_WAIT(); asm volatile("" ::: "memory");
#pragma unroll
        for (int j = 0; j < 4; ++j) { const int n = (lane >> 3) + 8 * j; const LAS float* s = scr + (8 * c) * 33 + n;
            v4u o; o.x = pk2(s[0 * 33], s[1 * 33]); o.y = pk2(s[2 * 33], s[3 * 33]); o.z = pk2(s[4 * 33], s[5 * 33]); o.w = pk2(s[6 * 33], s[7 * 33]);
            *(v4u*)(t.dst + (size_t)(32 * hf + n) * t.Kd + 8 * c) = o; }
        LDS_WAIT(); asm volatile("" ::: "memory");
    }
}
struct Dec0 { const float* w_in; bf16* WinT;
    __device__ __forceinline__ TI operator()(int r) const { const int nblk = NPROJ / 64, kb = r / nblk, nb = r % nblk; TI t; t.src = w_in + (size_t)(64 * kb) * NPROJ_ALL + 64 * nb; t.N = NPROJ_ALL; t.dst = WinT + (size_t)(64 * nb) * D + 64 * kb; t.Kd = D; return t; } };
struct Dec1 { const float *w_out, *w_gate, *w_up, *w_down; bf16 *WoT, *WguT, *WdT;
    __device__ __forceinline__ TI operator()(int r) const {
        constexpr int I_OUT = (D / 64) * (D / 64), I_G1 = (D / 64) * (FF / 64), I_G = NE * I_G1, I_D1 = (FF / 64) * (D / 64);
        TI t;
        if (r < I_OUT) { const int nblk = D / 64, kb = r / nblk, nb = r % nblk; t.src = w_out + (size_t)(64 * kb) * D + 64 * nb; t.N = D; t.dst = WoT + (size_t)(64 * nb) * D + 64 * kb; t.Kd = D; return t; }
        r -= I_OUT;
        if (r < 2 * I_G) { const int up = r >= I_G; if (up) r -= I_G; const int e = r / I_G1, q = r % I_G1, nblk = FF / 64, kb = q / nblk, nb = q % nblk, n0 = 64 * nb;
            const int drow = e * 2 * FF + (n0 >> 7) * 256 + up * 128 + (n0 & 127);
            t.src = (up ? w_up : w_gate) + (size_t)e * D * FF + (size_t)(64 * kb) * FF + n0; t.N = FF; t.dst = WguT + (size_t)drow * D + 64 * kb; t.Kd = D; return t; }
        r -= 2 * I_G;
        { const int e = r / I_D1, q = r % I_D1, nblk = D / 64, kb = q / nblk, nb = q % nblk;
          t.src = w_down + (size_t)e * FF * D + (size_t)(64 * kb) * D + 64 * nb; t.N = D; t.dst = WdT + ((size_t)e * D + 64 * nb) * FF + 64 * kb; t.Kd = FF; return t; }
    } };
template <class Dec>
__device__ __forceinline__ void conv_loop(const Dec dec, int total, int gw, int NGW, int lane, LAS float* scr) {
    int it = gw; if (it >= total) return;
    f32x4 va[16], vb[16];
    TI a = dec(it), b = a; t_issue(a, lane, va);
    for (;;) {
        const int itb = it + NGW; const bool hb = itb < total;
        if (hb) { b = dec(itb); t_issue(b, lane, vb); }
        t_finish(a, lane, va, scr);
        if (!hb) break;
        it = itb + NGW; const bool ha = it < total;
        if (ha) { a = dec(it); t_issue(a, lane, va); }
        t_finish(b, lane, vb, scr);
        if (!ha) break;
    }
}
template <int PART>
__device__ __forceinline__ void convert_weights(const Frame& F0) {
    PIN_FRAME(F);
    LAS float* scr = (LAS float*)(F.lds + RING_OFF + F.wave * 16384);
    const int gw = F.bx * NWAVES + F.wave, NGW = F.G * NWAVES;
    if (PART == 0) {
        conv_loop(Dec0{F.w_in, F.WinT}, (D / 64) * (NPROJ / 64), gw, NGW, F.lane, scr);
        for (int kb = gw; kb < D / 64; kb += NGW) transpose_item(F.w_in, NPROJ_ALL, F.WinT + (size_t)NPROJ * D, D, 64 * kb, NPROJ, scr, F.lane);
    } else {
        constexpr int TOTAL = (D / 64) * (D / 64);
        conv_loop(Dec1{F.w_out, F.w_gate, F.w_up, F.w_down, F.WoT, F.WguT, F.WdT}, TOTAL, gw, NGW, F.lane, scr);
    }
}
__device__ __forceinline__ void p0_prologue(const Frame& F0) {
    PIN_FRAME(F);
    const int gw = F.bx * NWAVES + F.wave, NGW = F.G * NWAVES;
    for (int m = gw; m < T; m += NGW) rms_row_to_bf16(F.x + (size_t)m * D, F.norm_attn_w, F.Hb + (size_t)m * D, F.lane);
    for (int i = F.bx * 512 + F.tid; i < (D / 32) * 3 * 2 * 64; i += F.G * 512) {
        const int ln = i & 63, p = (i >> 6) & 1, nt = (i >> 7) % 3, st = (i >> 7) / 3, c = 16 * nt + (ln & 15), k0 = 32 * st + 8 * (ln >> 4);
        unsigned h[8];
#pragma unroll
        for (int j = 0; j < 8; ++j) { const int k = k0 + j;
            const float wv = F.norm_ffn_w[k] * (c < 4 ? F.rg_w[k * NGRP + c] : (c < 16 ? 0.f : F.re_w[k * NE + c - 16]));
            const unsigned hi = f2bf(wv); h[j] = p ? f2bf(wv - __uint_as_float(hi << 16)) : hi; }
        ((v4u*)F.RW)[i] = (v4u){h[0] | (h[1] << 16), h[2] | (h[3] << 16), h[4] | (h[5] << 16), h[6] | (h[7] << 16)}; }
}
__device__ __forceinline__ void p1_dt(const Frame& F0) {
    PIN_FRAME(F);
    LAS float* red = (LAS float*)(F.lds + RING_OFF);
    const int fr = F.lane & 15, fq = F.lane >> 4;
    for (int item = F.bx; item < T / 16; item += 2 * F.G) {
        const bool has2 = item + F.G < T / 16;
        const int rowA = item * 16, rowB = (has2 ? item + F.G : item) * 16, kbase = F.wave * 512;
        f32x4 a0 = {0.f, 0.f, 0.f, 0.f}, a1 = a0, c0 = a0, c1 = a0;
        const bf16* apA = F.Hb + (size_t)(rowA + fr) * D + kbase + 8 * fq;
        const bf16* apB = F.Hb + (size_t)(rowB + fr) * D + kbase + 8 * fq;
        const bf16* b0p = F.WinT + (size_t)(NPROJ + fr) * D + kbase + 8 * fq;
        const bf16* b1p = F.WinT + (size_t)(NPROJ + 16 + fr) * D + kbase + 8 * fq;
#pragma unroll 4
        for (int s = 0; s < 16; ++s) {
            const bf16x8 xa = *(const bf16x8*)(apA + 32 * s), xb = *(const bf16x8*)(apB + 32 * s), b0 = *(const bf16x8*)(b0p + 32 * s), b1 = *(const bf16x8*)(b1p + 32 * s);
            a0 = __builtin_amdgcn_mfma_f32_16x16x32_bf16(xa, b0, a0, 0, 0, 0); a1 = __builtin_amdgcn_mfma_f32_16x16x32_bf16(xa, b1, a1, 0, 0, 0);
            c0 = __builtin_amdgcn_mfma_f32_16x16x32_bf16(xb, b0, c0, 0, 0, 0); c1 = __builtin_amdgcn_mfma_f32_16x16x32_bf16(xb, b1, c1, 0, 0, 0);
        }
        *(LAS f32x4*)(red + ((F.wave * 2 + 0) * 64 + F.lane) * 4) = a0; *(LAS f32x4*)(red + ((F.wave * 2 + 1) * 64 + F.lane) * 4) = a1;
        *(LAS f32x4*)(red + 4096 + ((F.wave * 2 + 0) * 64 + F.lane) * 4) = c0; *(LAS f32x4*)(red + 4096 + ((F.wave * 2 + 1) * 64 + F.lane) * 4) = c1;
        __syncthreads();
#pragma unroll
        for (int it = 0; it < 2; ++it) { if (it == 1 && !has2) break;
          const int row = F.tid >> 5, col = F.tid & 31, nt = col >> 4, ln = (row >> 2) * 16 + (col & 15), rg = row & 3, row0 = it ? rowB : rowA;
          float v = 0.f;
#pragma unroll
          for (int w = 0; w < 8; ++w) v += red[it * 4096 + ((w * 2 + nt) * 64 + ln) * 4 + rg];
          v += F.dt_bias[col];
          const float dt = v > 20.f ? v : log1pf(expf(v));
          F.DT[(size_t)(row0 + row) * SH + col] = dt; F.DA[(size_t)(row0 + row) * SH + col] = -dt * expf(F.a_log[col]); }
        __syncthreads();
    }
}

__constant__ double c_invfreq_rev[64] = {
0.15915494309189535,0.13782250260398285,0.11934937021124886,0.10335229661843406,0.089499401608891013,0.077503288755374058,0.067115083005227255,0.058119267441876246,0.050329212104487035,0.04358330210530733,0.037741584717419771,0.032682865872356998,0.028302195830623399,0.024508691862069852,0.02122365276477766,0.018378926105679667,0.015915494309189534,0.013782250260398284,0.011934937021124886,0.010335229661843406,0.0089499401608891024,0.0077503288755374055,0.0067115083005227253,0.0058119267441876241,0.0050329212104487037,0.0043583302105307331,0.0037741584717419772,0.0032682865872356993,0.0028302195830623399,0.0024508691862069852,0.0021223652764777662,0.0018378926105679667,0.0015915494309189536,0.0013782250260398288,0.0011934937021124885,0.0010335229661843405,0.00089499401608891024,0.00077503288755374051,0.0006711508300522726,0.00058119267441876239,0.00050329212104487033,0.00043583302105307329,0.00037741584717419774,0.00032682865872356992,0.00028302195830623395,0.00024508691862069854,0.00021223652764777661,0.00018378926105679666,0.00015915494309189535,0.00013782250260398286,0.00011934937021124886,0.00010335229661843406,8.9499401608891018e-05,7.7503288755374056e-05,6.7115083005227254e-05,5.8119267441876239e-05,5.0329212104487035e-05,4.3583302105307322e-05,3.7741584717419777e-05,3.2682865872356999e-05,2.8302195830623396e-05,2.4508691862069852e-05,2.1223652764777659e-05,1.8378926105679668e-05};

struct QkRaw { v4u a0, a1, b0, b1; };
__device__ __forceinline__ QkRaw qk_load(const bf16* src, int lane) {
    const int hh = lane >> 2, sub = lane & 3;
    const v4u* p1 = (const v4u*)(src + hh * HD + 16 * sub); const v4u* p2 = (const v4u*)(src + hh * HD + 64 + 16 * sub);
    QkRaw r; r.a0 = p1[0]; r.a1 = p1[1]; r.b0 = p2[0]; r.b1 = p2[1]; return r;
}
__device__ __forceinline__ void qk_norm_rope(const QkRaw& raw, const float* nw, bf16* dst, const LAS float* cs, int lane) {
    const int hh = lane >> 2, sub = lane & 3;
    const v4u a0 = raw.a0, a1 = raw.a1, b0 = raw.b0, b1 = raw.b1;
    float t1[16], t2[16];
    { const unsigned aw[8] = {a0.x, a0.y, a0.z, a0.w, a1.x, a1.y, a1.z, a1.w}, bw[8] = {b0.x, b0.y, b0.z, b0.w, b1.x, b1.y, b1.z, b1.w};
#pragma unroll
      for (int i = 0; i < 8; ++i) { t1[2 * i] = bflo(aw[i]); t1[2 * i + 1] = bfhi(aw[i]); t2[2 * i] = bflo(bw[i]); t2[2 * i + 1] = bfhi(bw[i]); } }
    float s = 0.f;
#pragma unroll
    for (int i = 0; i < 16; ++i) s += t1[i] * t1[i] + t2[i] * t2[i];
    s += __shfl_xor(s, 1); s += __shfl_xor(s, 2);
    const float rstd = 1.0f / sqrtf(s * (1.f / HD) + NORM_EPS);
    unsigned o1[8], o2[8];
#pragma unroll
    for (int i = 0; i < 8; ++i) {
        float r1[2], r2[2];
#pragma unroll
        for (int e = 0; e < 2; ++e) { const int j = 2 * i + e, fi = 16 * sub + j; const float y1 = t1[j] * rstd * nw[fi], y2 = t2[j] * rstd * nw[64 + fi]; const float c = cs[fi], sn = cs[64 + fi];
            r1[e] = y1 * c - y2 * sn; r2[e] = y2 * c + y1 * sn; }
        o1[i] = pk2(r1[0], r1[1]); o2[i] = pk2(r2[0], r2[1]);
    }
    v4u* q1 = (v4u*)(dst + hh * HD + 16 * sub); v4u* q2 = (v4u*)(dst + hh * HD + 64 + 16 * sub);
    q1[0] = (v4u){o1[0], o1[1], o1[2], o1[3]}; q1[1] = (v4u){o1[4], o1[5], o1[6], o1[7]};
    q2[0] = (v4u){o2[0], o2[1], o2[2], o2[3]}; q2[1] = (v4u){o2[4], o2[5], o2[6], o2[7]};
}
__device__ __forceinline__ void p2_prep(const Frame& F0) {
    PIN_FRAME(F);
    const int gw = F.bx * NWAVES + F.wave, NGW = F.G * NWAVES;
    LAS float* cs = (LAS float*)(F.lds + RING_OFF + F.wave * 1024);
    for (int row = gw; row < T; row += 2 * NGW) {
        const int row2 = row + NGW < T ? row + NGW : row;
        const QkRaw qraw = qk_load(F.PROJ + (size_t)row * NPROJ + Q0, F.lane), kraw = qk_load(F.PROJ + (size_t)row * NPROJ + K0, F.lane);
        const QkRaw qraw2 = qk_load(F.PROJ + (size_t)row2 * NPROJ + Q0, F.lane), kraw2 = qk_load(F.PROJ + (size_t)row2 * NPROJ + K0, F.lane);
        const double r = (double)F.pos[row] * c_invfreq_rev[F.lane], r2 = (double)F.pos[row2] * c_invfreq_rev[F.lane];
        const float fr = (float)(r - floor(r)), fr2 = (float)(r2 - floor(r2));
        cs[F.lane] = __builtin_amdgcn_cosf(fr); cs[64 + F.lane] = __builtin_amdgcn_sinf(fr);
        cs[128 + F.lane] = __builtin_amdgcn_cosf(fr2); cs[192 + F.lane] = __builtin_amdgcn_sinf(fr2);
        LDS_WAIT(); asm volatile("" ::: "memory");
        qk_norm_rope(qraw, F.q_norm_w, F.QN + (size_t)row * AW, cs, F.lane);
        qk_norm_rope(kraw, F.k_norm_w, F.KN + (size_t)row * AW, cs, F.lane);
        if (row2 != row) {
            qk_norm_rope(qraw2, F.q_norm_w, F.QN + (size_t)row2 * AW, cs + 128, F.lane);
            qk_norm_rope(kraw2, F.k_norm_w, F.KN + (size_t)row2 * AW, cs + 128, F.lane); }
        LDS_WAIT(); asm volatile("" ::: "memory");
    }
    for (int it = F.bx * 512 + F.tid; it < (T / 32) * 512; it += F.G * 512) {
        const int rb = it >> 9, ch = (it & 511) * 8, row0 = rb * 32, s0 = row0 & (SEQ - 1);
        float w[4][8], bias[8];
#pragma unroll
        for (int j = 0; j < 4; ++j) { const f32x4 wa = *(const f32x4*)(F.conv_w + j * 4096 + ch), wb = *(const f32x4*)(F.conv_w + j * 4096 + ch + 4);
            w[j][0] = wa.x; w[j][1] = wa.y; w[j][2] = wa.z; w[j][3] = wa.w; w[j][4] = wb.x; w[j][5] = wb.y; w[j][6] = wb.z; w[j][7] = wb.w; }
        { const f32x4 ba = *(const f32x4*)(F.conv_b + ch), bb = *(const f32x4*)(F.conv_b + ch + 4); bias[0] = ba.x; bias[1] = ba.y; bias[2] = ba.z; bias[3] = ba.w; bias[4] = bb.x; bias[5] = bb.y; bias[6] = bb.z; bias[7] = bb.w; }
        v4u win0, win1, win2;
        const bf16* src = F.PROJ + (size_t)row0 * NPROJ + XBC0 + ch;
        const v4u zero = {0u, 0u, 0u, 0u};
        win0 = s0 ? *(const v4u*)(src - 3 * (size_t)NPROJ) : zero; win1 = s0 ? *(const v4u*)(src - 2 * (size_t)NPROJ) : zero; win2 = s0 ? *(const v4u*)(src - (size_t)NPROJ) : zero;
#pragma unroll 4
        for (int t = 0; t < 32; ++t) {
            const v4u cur = *(const v4u*)(src + (size_t)t * NPROJ);
            const unsigned a0[4] = {win0.x, win0.y, win0.z, win0.w}, a1[4] = {win1.x, win1.y, win1.z, win1.w}, a2[4] = {win2.x, win2.y, win2.z, win2.w}, a3[4] = {cur.x, cur.y, cur.z, cur.w};
            unsigned o[4];
#pragma unroll
            for (int i = 0; i < 4; ++i) {
                const float lo = bias[2 * i] + w[0][2 * i] * bflo(a0[i]) + w[1][2 * i] * bflo(a1[i]) + w[2][2 * i] * bflo(a2[i]) + w[3][2 * i] * bflo(a3[i]);
                const float hi = bias[2 * i + 1] + w[0][2 * i + 1] * bfhi(a0[i]) + w[1][2 * i + 1] * bfhi(a1[i]) + w[2][2 * i + 1] * bfhi(a2[i]) + w[3][2 * i + 1] * bfhi(a3[i]);
                o[i] = pk2(silu_f(lo), silu_f(hi));
            }
            *(v4u*)(F.XC + (size_t)(row0 + t) * 4096 + ch) = (v4u){o[0], o[1], o[2], o[3]};
            win0 = win1; win1 = win2; win2 = cur;
        }
    }
}

__device__ __forceinline__ void p3_attention_simple(const Frame& F0) {
    PIN_FRAME(F);
    const unsigned* QN32 = (const unsigned*)F.QN; const unsigned* KN32 = (const unsigned*)F.KN; const unsigned* PJ32 = (const unsigned*)F.PROJ;
    const float C2 = 0.08838834764831845f * 1.4426950408889634f;
    for (int item = F.bx * NWAVES + F.wave; item < T * NH; item += F.G * NWAVES) {
        const int s = item & (SEQ - 1), bh = item >> 11, h = bh & (NH - 1), b = bh >> 4, row = b * SEQ + s;
        const unsigned qw = QN32[(size_t)row * (AW / 2) + h * 64 + F.lane];
        const float q0 = bflo(qw) * C2, q1 = bfhi(qw) * C2;
        float m = -1e30f, l = 0.f, a0 = 0.f, a1 = 0.f;
#pragma unroll 1
        for (int br = 0; br < 3; ++br) {
            const int dil = br == 0 ? 1 : (br == 1 ? 4 : 16);
            int nk = s / dil; nk = (nk > 128 ? 128 : nk) + 1;
#pragma unroll 1
            for (int j0 = 0; j0 < nk; j0 += 8) {
                unsigned kw[8], vw[8];
#pragma unroll
                for (int u = 0; u < 8; ++u) { const int j = j0 + u, jj = j < nk ? j : 0; const size_t kr = (size_t)(row - jj * dil);
                    kw[u] = KN32[kr * (AW / 2) + h * 64 + F.lane]; vw[u] = PJ32[kr * (NPROJ / 2) + V0 / 2 + h * 64 + F.lane]; }
#pragma unroll
                for (int u = 0; u < 8; ++u) {
                    float sc = wave_sum(q0 * bflo(kw[u]) + q1 * bfhi(kw[u]));
                    if (j0 + u >= nk) sc = -__builtin_inff();
                    const float mn = fmaxf(m, sc), corr = __builtin_amdgcn_exp2f(m - mn), p = __builtin_amdgcn_exp2f(sc - mn);
                    l = l * corr + p; a0 = a0 * corr + p * bflo(vw[u]); a1 = a1 * corr + p * bfhi(vw[u]); m = mn;
                }
            }
        }
        const float inv = 1.0f / l;
        ((unsigned*)F.MIX)[(size_t)row * (D / 2) + h * 64 + F.lane] = pk2(a0 * inv, a1 * inv);
    }
}

namespace att {
constexpr float SCALE = 0.08838834764831845f;
constexpr float THR = 8.f;
constexpr int KVBLK = 64, SHM_K = 16384, SHM_V = 16384;
typedef float f32x16 __attribute__((ext_vector_type(16)));
typedef short s16x4 __attribute__((ext_vector_type(4)));
#define KSWZ(row, colB) ((row) * 256 + ((colB) ^ (((row) & 7) << 4)))
#define SBAR() __builtin_amdgcn_sched_barrier(0)
__device__ __forceinline__ int v_st(int k, int c) { const int kk = (k & ~0xC) | ((k & 4) << 1) | ((k & 8) >> 1); return ((kk >> 3) * 4 + (c >> 5)) * 512 + ((kk & 7) * 32 + (c & 31)) * 2; }
__device__ __forceinline__ int v_rd_base(int lane) { return ((lane & 3) << 3) | (((lane >> 2) & 3) << 6) | (((lane >> 4) & 1) << 5) | (((lane >> 5) & 1) << 8); }
constexpr int v_rd_off(int d0, int ks, int half) { return d0 * 512 + ks * 4096 + half * 2048; }
__device__ __forceinline__ int crow(int r, int hi) { return (r & 3) + 8 * (r >> 2) + 4 * hi; }
__device__ __forceinline__ unsigned cvtpk(float lo, float hi) { unsigned r; asm volatile("v_cvt_pk_bf16_f32 %0, %1, %2" : "=v"(r) : "v"(lo), "v"(hi)); return r; }
__device__ __forceinline__ void mask_tile(f32x16& p0, f32x16& p1, int dq, unsigned W) {
    const float NEG = -__builtin_inff();
#pragma unroll
    for (int r = 0; r < 16; ++r) {
        const int c = (r & 3) + 8 * (r >> 2);
        if ((unsigned)(dq - c) >= W) p0[r] = NEG;
        if ((unsigned)(dq - c - 32) >= W) p1[r] = NEG;
    }
}
__device__ __forceinline__ void partialSM(f32x16& p0, f32x16& p1, float& m_reg, float& mn, float& alpha) {
    float pmax = p0[0];
#pragma unroll
    for (int r = 1; r < 16; ++r) pmax = fmaxf(pmax, p0[r]);
#pragma unroll
    for (int r = 0; r < 16; ++r) pmax = fmaxf(pmax, p1[r]);
    { auto rr = __builtin_amdgcn_permlane32_swap(__float_as_uint(pmax), __float_as_uint(pmax), false, false);
      pmax = fmaxf(__uint_as_float(rr[0]), __uint_as_float(rr[1])); }
    constexpr float C2 = 1.4426950408889634f * SCALE;
    if (__builtin_expect(__all((pmax - m_reg) * SCALE <= THR), 1)) { mn = m_reg; alpha = 1.f; }
    else { mn = fmaxf(m_reg, pmax); alpha = __builtin_amdgcn_exp2f((m_reg - mn) * C2); m_reg = mn; }
    const float mnL = -mn * C2;
#pragma unroll
    for (int r = 0; r < 16; ++r) p0[r] = fmaf(p0[r], C2, mnL);
#pragma unroll
    for (int r = 0; r < 16; ++r) p1[r] = fmaf(p1[r], C2, mnL);
#pragma unroll
    for (int r = 0; r < 16; ++r) p0[r] = __builtin_amdgcn_exp2f(p0[r]);
}
#define ATT_PK4(P, B_, OUT) do { unsigned a0 = att::cvtpk(P[B_+0], P[B_+1]), a1 = att::cvtpk(P[B_+2], P[B_+3]);                          \
        unsigned b0 = att::cvtpk(P[B_+4], P[B_+5]), b1 = att::cvtpk(P[B_+6], P[B_+7]);                                             \
        auto r0 = __builtin_amdgcn_permlane32_swap(a0, b0, false, false); auto r1 = __builtin_amdgcn_permlane32_swap(a1, b1, false, false); \
        v4u w = {r0[0], r1[0], r0[1], r1[1]}; OUT = *reinterpret_cast<bf16x8*>(&w); } while (0)
__device__ __forceinline__ void finishSM(f32x16& p0, f32x16& p1, float alpha, float& l_reg, bf16x8& pa0, bf16x8& pa1, bf16x8& pa2, bf16x8& pa3) {
#pragma unroll
    for (int r = 0; r < 16; ++r) p1[r] = __builtin_amdgcn_exp2f(p1[r]);
    float ps = 0;
#pragma unroll
    for (int r = 0; r < 16; ++r) ps += p0[r];
#pragma unroll
    for (int r = 0; r < 16; ++r) ps += p1[r];
    { auto rr = __builtin_amdgcn_permlane32_swap(__float_as_uint(ps), __float_as_uint(ps), false, false);
      ps = __uint_as_float(rr[0]) + __uint_as_float(rr[1]); }
    l_reg = l_reg * alpha + ps;
    ATT_PK4(p0, 0, pa0); ATT_PK4(p0, 8, pa1); ATT_PK4(p1, 0, pa2); ATT_PK4(p1, 8, pa3);
}
__device__ __forceinline__ void qkt(f32x16& p0, f32x16& p1, const LAS unsigned char* klds, int r32, int hi, const bf16x8* qr) {
    p0 = f32x16{}; p1 = f32x16{};
    const LAS unsigned char* kb[4];
#pragma unroll
    for (int dd = 0; dd < 4; ++dd) kb[dd] = klds + KSWZ(r32, (dd * 16 + hi * 8) * 2);
#pragma unroll
    for (int d0 = 0; d0 < 8; ++d0) { const LAS unsigned char* a = kb[d0 & 3] + (d0 >> 2) * 128;
        const bf16x8 b0 = *reinterpret_cast<const LAS bf16x8*>(a);
        const bf16x8 b1 = *reinterpret_cast<const LAS bf16x8*>(a + 32 * 256);
        p0 = __builtin_amdgcn_mfma_f32_32x32x16_bf16(b0, qr[d0], p0, 0, 0, 0);
        p1 = __builtin_amdgcn_mfma_f32_32x32x16_bf16(b1, qr[d0], p1, 0, 0, 0); }
}
#define ATT_TRRD(dst, off) asm volatile("ds_read_b64_tr_b16 %0, %1 offset:%2" : "=&v"(dst) : "v"(vb0), "i"(off) : "memory")
#define ATT_PV_D0(o_, d0, q0, q1, q2, q3) do { att::s16x4 l0, l1, l2, l3, h0, h1, h2, h3; constexpr int b_ = att::v_rd_off(d0, 0, 0); \
        ATT_TRRD(l0, b_); ATT_TRRD(h0, b_ + 2048); ATT_TRRD(l1, b_ + 4096); ATT_TRRD(h1, b_ + 6144); ATT_TRRD(l2, b_ + 8192); ATT_TRRD(h2, b_ + 10240); ATT_TRRD(l3, b_ + 12288); ATT_TRRD(h3, b_ + 14336); \
        asm volatile("s_waitcnt lgkmcnt(0)" ::: "memory"); SBAR();   \
        o_ = __builtin_amdgcn_mfma_f32_32x32x16_bf16(q0, (bf16x8){l0[0], l0[1], l0[2], l0[3], h0[0], h0[1], h0[2], h0[3]}, o_, 0, 0, 0);   \
        o_ = __builtin_amdgcn_mfma_f32_32x32x16_bf16(q1, (bf16x8){l1[0], l1[1], l1[2], l1[3], h1[0], h1[1], h1[2], h1[3]}, o_, 0, 0, 0);   \
        o_ = __builtin_amdgcn_mfma_f32_32x32x16_bf16(q2, (bf16x8){l2[0], l2[1], l2[2], l2[3], h2[0], h2[1], h2[2], h2[3]}, o_, 0, 0, 0);   \
        o_ = __builtin_amdgcn_mfma_f32_32x32x16_bf16(q3, (bf16x8){l3[0], l3[1], l3[2], l3[3], h3[0], h3[1], h3[2], h3[3]}, o_, 0, 0, 0); } while (0)
}

struct AttUnit { int br, dil, n, h, kt0, NT, qlo; size_t rowb; };
__device__ __forceinline__ AttUnit att_decode(int u, int hw, int wv4) {
    AttUnit a; const int br = u >> 9, v = u & 511; int dil, b, r, n, hp;
    if (br == 0) { dil = 16; hp = v & 7; r = (v >> 3) & 15; b = v >> 7; n = 0; }
    else if (br == 1) { dil = 4; n = ((v >> 8) + v) & 3; hp = (v >> 2) & 7; r = (v >> 5) & 3; b = v >> 7; }
    else { dil = 1; n = ((v >> 8) * 8 + v) & 15; hp = (v >> 4) & 7; b = (v >> 7) & 3; r = 0; }
    a.br = br; a.dil = dil; a.n = n; a.h = 2 * hp + hw; a.kt0 = n == 0 ? 0 : (n - 1) * 2; a.NT = n == 0 ? 2 : 4;
    a.rowb = (size_t)b * SEQ + r; a.qlo = n * 128 + wv4 * 32; return a;
}
__device__ __forceinline__ void p3_attention_mfma(const Frame& F0) {
    PIN_FRAME(F);
    using att::f32x16;
    const int lane = F.lane, r32 = lane & 31, hi = lane >> 5, hw = F.wave >> 2, wv4 = F.wave & 3, th = F.tid & 255;
    LAS unsigned char* Vl = F.lds + RING_OFF + hw * 65536;
    LAS unsigned char* Kl = Vl + 2 * att::SHM_V;
    LAS float* wsf = (LAS float*)(F.lds + L_ATT) + F.wave * 64; LAS float* li_l = wsf; LAS float* al_l = wsf + 32;
    const int sr = th >> 4, sc = (th & 15) * 8;
    int kws[4], vst[4];
#pragma unroll
    for (int i = 0; i < 4; ++i) { kws[i] = KSWZ(sr + 16 * i, sc * 2); vst[i] = att::v_st(sr + 16 * i, sc); }
    const int vb_base = (int)(uintptr_t)Vl + att::v_rd_base(lane);
    int u = F.bx; if (u >= 1536) return;
    AttUnit cur = att_decode(u, hw, wv4);
    bf16x8 qr[8]; v4u sk[4], sv[4];
#define ATT_LOADQ(A_) do { const bf16* qp = F.QN + ((A_).rowb + (size_t)((A_).qlo + r32) * (A_).dil) * AW + (A_).h * HD + hi * 8; \
        _Pragma("unroll") for (int d0 = 0; d0 < 8; ++d0) qr[d0] = *(const bf16x8*)(qp + d0 * 16); } while (0)
#define ATT_LOAD(A_, t_) do { const int kb_ = ((A_).kt0 + (t_)) * 64; _Pragma("unroll") for (int i = 0; i < 4; ++i) { const size_t gr = (A_).rowb + (size_t)(kb_ + sr + 16 * i) * (A_).dil; \
        sk[i] = *(const v4u*)(F.KN + gr * AW + (A_).h * HD + sc); sv[i] = *(const v4u*)(F.PROJ + gr * NPROJ + V0 + (A_).h * HD + sc); } } while (0)
#define ATT_WRITE(bf_) do { _Pragma("unroll") for (int i = 0; i < 4; ++i) { *(LAS v4u*)(Kl + (bf_) * att::SHM_K + kws[i]) = sk[i]; *(LAS v4u*)(Vl + (bf_) * att::SHM_V + vst[i]) = sv[i]; } } while (0)
    ATT_LOADQ(cur); ATT_LOAD(cur, 0);
#pragma unroll 1
    for (;;) {
        const int un = u + F.G; const bool has = un < 1536; const AttUnit nxt = att_decode(has ? un : u, hw, wv4);
        const int NT = cur.NT, qlo = cur.qlo, qm = qlo + r32 - 4 * hi;
        ATT_WRITE(0);
        __syncthreads();
        float m_reg = -1e30f, l_reg = 0.f; f32x16 o[4] = {};
#pragma unroll 1
        for (int t = 0; t < NT; ++t) {
            const int bf = t & 1;
            if (t + 1 < NT) ATT_LOAD(cur, t + 1); else if (has) ATT_LOAD(nxt, 0);
            const int kb = (cur.kt0 + t) * 64;
            const bool act = (kb <= qlo + 31) && (kb + 63 >= qlo - 128);
            if (act) {
                f32x16 p0, p1; float mn, al; bf16x8 pa0, pa1, pa2, pa3;
                att::qkt(p0, p1, Kl + bf * att::SHM_K, r32, hi, qr);
                att::mask_tile(p0, p1, qm - kb, 129u);
                att::partialSM(p0, p1, m_reg, mn, al);
                if (__any(al < 1.f)) { if (hi == 0) al_l[r32] = al; asm volatile("s_waitcnt lgkmcnt(0)" ::: "memory");
#pragma unroll
                    for (int d_ = 0; d_ < 4; ++d_)
#pragma unroll
                        for (int rr = 0; rr < 16; ++rr) o[d_][rr] *= al_l[att::crow(rr, hi)];
                    asm volatile("s_waitcnt lgkmcnt(0)" ::: "memory"); }
                att::finishSM(p0, p1, al, l_reg, pa0, pa1, pa2, pa3);
                const int vb0 = vb_base + bf * att::SHM_V;
                ATT_PV_D0(o[0], 0, pa0, pa1, pa2, pa3); ATT_PV_D0(o[1], 1, pa0, pa1, pa2, pa3); ATT_PV_D0(o[2], 2, pa0, pa1, pa2, pa3); ATT_PV_D0(o[3], 3, pa0, pa1, pa2, pa3);
            }
            if (t + 1 < NT) ATT_WRITE(bf ^ 1);
            else if (has) ATT_LOADQ(nxt);
            __syncthreads();
        }
        if (hi == 0) li_l[r32] = l_reg;
        asm volatile("s_waitcnt lgkmcnt(0)" ::: "memory");
        bf16* Ob = F.OBR + (size_t)cur.br * T * AW + cur.h * HD;
#pragma unroll
        for (int rr = 0; rr < 16; ++rr) { const int orow = att::crow(rr, hi); const float rli = __builtin_amdgcn_rcpf(li_l[orow]);
            bf16* op = Ob + (cur.rowb + (size_t)(qlo + orow) * cur.dil) * AW;
#pragma unroll
            for (int d0 = 0; d0 < 4; ++d0) { const float vv = o[d0][rr] * rli; const float vn = __shfl_xor(vv, 1);
                if ((r32 & 1) == 0) *(unsigned*)(op + d0 * 32 + r32) = att::cvtpk(vv, vn); } }
        if (hi == 0) { float* mlp = F.ML + (((size_t)cur.br * T + cur.rowb + (size_t)(qlo + r32) * cur.dil) * NH + cur.h) * 2; *(f32x2*)mlp = (f32x2){m_reg, l_reg}; }
        asm volatile("s_waitcnt lgkmcnt(0)" ::: "memory");
        if (!has) break;
        cur = nxt; u = un;
    }
#undef ATT_LOADQ
#undef ATT_LOAD
#undef ATT_WRITE
}
__device__ __forceinline__ void p4_attn_combine(const Frame& F0) {
    PIN_FRAME(F);
    const int gw = F.bx * NWAVES + F.wave, NGW = F.G * NWAVES;
    constexpr float C2 = 1.4426950408889634f * att::SCALE;
#pragma unroll 2
    for (int row = gw; row < T; row += NGW) {
        const int hh = F.lane >> 2;
        f32x2 ml[3]; float M = -3e38f;
#pragma unroll
        for (int b_ = 0; b_ < 3; ++b_) { ml[b_] = *(const f32x2*)(F.ML + (((size_t)b_ * T + row) * NH + hh) * 2); M = fmaxf(M, ml[b_].x); }
        float w[3], ws = 0.f;
#pragma unroll
        for (int b_ = 0; b_ < 3; ++b_) { w[b_] = ml[b_].y * __builtin_amdgcn_exp2f((ml[b_].x - M) * C2); ws += w[b_]; }
        const float inv = 1.0f / ws;
        float acc[32];
#pragma unroll
        for (int i = 0; i < 32; ++i) acc[i] = 0.f;
#pragma unroll
        for (int b_ = 0; b_ < 3; ++b_) { const v4u* p = (const v4u*)(F.OBR + ((size_t)b_ * T + row) * AW + 32 * F.lane); const float wb = w[b_] * inv;
#pragma unroll
            for (int j = 0; j < 4; ++j) { const v4u q = p[j]; const unsigned qq[4] = {q.x, q.y, q.z, q.w};
#pragma unroll
                for (int e = 0; e < 4; ++e) { acc[8 * j + 2 * e] += wb * bflo(qq[e]); acc[8 * j + 2 * e + 1] += wb * bfhi(qq[e]); } } }
        v4u* op = (v4u*)(F.MIX + (size_t)row * D + 32 * F.lane);
#pragma unroll
        for (int j = 0; j < 4; ++j) op[j] = (v4u){pk2(acc[8 * j], acc[8 * j + 1]), pk2(acc[8 * j + 2], acc[8 * j + 3]), pk2(acc[8 * j + 4], acc[8 * j + 5]), pk2(acc[8 * j + 6], acc[8 * j + 7])};
    }
}

#define SSD_TRRD(dst, base, off) asm volatile("ds_read_b64_tr_b16 %0, %1 offset:%2" : "=&v"(dst) : "v"(base), "i"(off) : "memory")
#define SSD_MKFRAG(l_, h_) ((bf16x8){l_[0], l_[1], l_[2], l_[3], h_[0], h_[1], h_[2], h_[3]})
__device__ __forceinline__ void ssd_cumsum(const Frame& F, int row0, int g, LAS float* csL, float* ct_out) {
    if (F.wave < 4) { const int hh = F.wave; const float* dap = F.DA + (size_t)(row0 + 4 * F.lane) * SH + 4 * g + hh;
        const float a0 = dap[0], a1 = dap[SH], a2 = dap[2 * SH], a3 = dap[3 * SH];
        const float s1 = a0 + a1, s2 = s1 + a2, s3 = s2 + a3; float t = s3;
#pragma unroll
        for (int off = 1; off < 64; off <<= 1) { const float v = __shfl_up(t, off); if (F.lane >= off) t += v; }
        const float ex = t - s3;
        *(LAS f32x4*)(csL + hh * 256 + 4 * F.lane) = (f32x4){ex + a0, ex + s1, ex + s2, ex + s3};
        if (ct_out && F.lane == 63) ct_out[hh] = ex + s3; }
}
__device__ __forceinline__ v4u scale8(v4u q, float w) {
    v4u o; o.x = pk2(bflo(q.x) * w, bfhi(q.x) * w); o.y = pk2(bflo(q.y) * w, bfhi(q.y) * w); o.z = pk2(bflo(q.z) * w, bfhi(q.z) * w); o.w = pk2(bflo(q.w) * w, bfhi(q.w) * w); return o;
}
__device__ __forceinline__ void p3_ssd_states(const Frame& F0) {
    PIN_FRAME(F);
    using att::s16x4;
    LAS float* csL = (LAS float*)(F.lds + RING_OFF);
    LAS float* wL = (LAS float*)(F.lds + RING_OFF + 4096);
    LAS unsigned char* BT = F.lds + RING_OFF + 16384;
    LAS unsigned char* XT = F.lds + RING_OFF + 32768;
    const int lane = F.lane, r32 = lane & 31, hi = lane >> 5, sr = F.tid >> 4, sc = (F.tid & 15) * 8;
    for (int item = F.bx; item < NB * 8 * SG; item += F.G) {
        const int g = item & 7, c = (item >> 3) & 7, b = item >> 6, row0 = b * SEQ + c * 256;
        ssd_cumsum(F, row0, g, csL, F.CT + (size_t)(b * 8 + c) * SH + 4 * g);
        __syncthreads();
        for (int i = F.tid; i < 1024; i += NWAVES * 64) { const int hh = i >> 8, l = i & 255;
            wL[i] = F.DT[(size_t)(row0 + l) * SH + 4 * g + hh] * __expf(csL[hh * 256 + 255] - csL[i]); }
        __syncthreads();
        const int hh = F.wave >> 1, pb = F.wave & 1;
        const int vbB = (int)(uintptr_t)BT + att::v_rd_base(lane);
        const int vbX = (int)(uintptr_t)XT + (hh >> 1) * 16384 + ((hh & 1) * 2 + pb) * 512 + att::v_rd_base(lane);
        att::f32x16 acc[4] = {};
        v4u sb[2], sx[2][2];
#define SSDA_LOAD(j_) do { _Pragma("unroll") for (int i = 0; i < 2; ++i) { const int l = 64 * (j_) + sr + 32 * i; const bf16* rp = F.XC + (size_t)(row0 + l) * 4096; \
            sb[i] = *(const v4u*)(rp + 2048 + g * SN + sc); \
            _Pragma("unroll") for (int tt = 0; tt < 2; ++tt) sx[i][tt] = scale8(*(const v4u*)(rp + g * 256 + tt * 128 + sc), wL[(tt * 2 + (sc >> 6)) * 256 + l]); } } while (0)
        SSDA_LOAD(0);
        for (int j = 0; j < 4; ++j) {
#pragma unroll
            for (int i = 0; i < 2; ++i) { const int rl = sr + 32 * i;
                *(LAS v4u*)(BT + att::v_st(rl, sc)) = sb[i];
#pragma unroll
                for (int tt = 0; tt < 2; ++tt) *(LAS v4u*)(XT + tt * 16384 + att::v_st(rl, sc)) = sx[i][tt]; }
            __syncthreads();
            if (j + 1 < 4) SSDA_LOAD(j + 1);
#define SSDA_KS(ks) do { s16x4 al0, ah0, al1, ah1, al2, ah2, al3, ah3, xl, xh; \
            SSD_TRRD(al0, vbB, 0 * 512 + (ks) * 4096); SSD_TRRD(ah0, vbB, 0 * 512 + (ks) * 4096 + 2048); SSD_TRRD(al1, vbB, 1 * 512 + (ks) * 4096); SSD_TRRD(ah1, vbB, 1 * 512 + (ks) * 4096 + 2048); \
            SSD_TRRD(al2, vbB, 2 * 512 + (ks) * 4096); SSD_TRRD(ah2, vbB, 2 * 512 + (ks) * 4096 + 2048); SSD_TRRD(al3, vbB, 3 * 512 + (ks) * 4096); SSD_TRRD(ah3, vbB, 3 * 512 + (ks) * 4096 + 2048); \
            SSD_TRRD(xl, vbX, (ks) * 4096); SSD_TRRD(xh, vbX, (ks) * 4096 + 2048); \
            asm volatile("s_waitcnt lgkmcnt(0)" ::: "memory"); __builtin_amdgcn_sched_barrier(0); \
            const bf16x8 xf = SSD_MKFRAG(xl, xh); \
            acc[0] = __builtin_amdgcn_mfma_f32_32x32x16_bf16(SSD_MKFRAG(al0, ah0), xf, acc[0], 0, 0, 0); acc[1] = __builtin_amdgcn_mfma_f32_32x32x16_bf16(SSD_MKFRAG(al1, ah1), xf, acc[1], 0, 0, 0); \
            acc[2] = __builtin_amdgcn_mfma_f32_32x32x16_bf16(SSD_MKFRAG(al2, ah2), xf, acc[2], 0, 0, 0); acc[3] = __builtin_amdgcn_mfma_f32_32x32x16_bf16(SSD_MKFRAG(al3, ah3), xf, acc[3], 0, 0, 0); } while (0)
            SSDA_KS(0); SSDA_KS(1); SSDA_KS(2); SSDA_KS(3);
#undef SSDA_KS
            __syncthreads();
        }
#undef SSDA_LOAD
        float* stp = F.ST + ((size_t)((b * 8 + c) * SH + 4 * g + hh) * SP + 32 * pb + r32) * SN;
#pragma unroll
        for (int nb = 0; nb < 4; ++nb)
#pragma unroll
            for (int q = 0; q < 4; ++q) *(f32x4*)(stp + 32 * nb + 8 * q + 4 * hi) = (f32x4){acc[nb][4 * q], acc[nb][4 * q + 1], acc[nb][4 * q + 2], acc[nb][4 * q + 3]};
    }
}
__device__ __forceinline__ void p4_ssd_out(const Frame& F0) {
    PIN_FRAME(F);
    using att::f32x16;
    LAS float* csL = (LAS float*)(F.lds + L_SSD);
    LAS float* dtL = (LAS float*)(F.lds + L_SSD + 4096);
    LAS float* facL = (LAS float*)(F.lds + L_SSD + 8192);
    LAS unsigned char* BK = F.lds + RING_OFF;
    LAS unsigned char* PT = F.lds + RING_OFF + 65536;
    LAS unsigned char* VT = F.lds + RING_OFF + 81920;
    LAS float* ep = (LAS float*)(F.lds + RING_OFF + 65536 + F.wave * 8192);
    const int lane = F.lane, r32 = lane & 31, hi = lane >> 5, w = F.wave;
    const int vb_base = (int)(uintptr_t)VT + att::v_rd_base(lane);
#pragma unroll 1
    for (int item = F.bx; item < NB * 8 * SG; item += F.G) {
        const int g = item & 7, c = (item >> 3) & 7, b = item >> 6, row0 = b * SEQ + c * 256;
        ssd_cumsum(F, row0, g, csL, nullptr);
        for (int i = F.tid; i < 1024; i += NWAVES * 64) dtL[i] = F.DT[(size_t)(row0 + (i & 255)) * SH + 4 * g + (i >> 8)];
        if (F.tid < 32) { const int cp = F.tid >> 2, hh = F.tid & 3; float ctv[8];
#pragma unroll
            for (int j = 0; j < 8; ++j) ctv[j] = F.CT[(size_t)(b * 8 + j) * SH + 4 * g + hh];
            float e = 0.f;
#pragma unroll
            for (int j = 0; j < 8; ++j) e += (j > cp && j < c) ? ctv[j] : 0.f;
            facL[F.tid] = cp < c ? __expf(e) : 0.f; }
#pragma unroll 8
        for (int ch = F.tid; ch < 4096; ch += NWAVES * 64) { const int l = ch >> 4, pc = ch & 15;
            *(LAS v4u*)(BK + (l >> 6) * 16384 + KSWZ(l & 63, pc * 16)) = *(const v4u*)(F.XC + (size_t)(row0 + l) * 4096 + 2048 + g * SN + pc * 8); }
        bf16x8 qr[8];
        { const bf16* cp_ = F.XC + (size_t)(row0 + 32 * w + r32) * 4096 + 3072 + g * SN + hi * 8;
#pragma unroll
          for (int d0 = 0; d0 < 8; ++d0) qr[d0] = *(const bf16x8*)(cp_ + d0 * 16); }
        __syncthreads();
#pragma unroll 1
        for (int hh = 0; hh < 4; ++hh) {
            int tid_ = F.tid; asm volatile("" : "+v"(tid_));
            const int vr = tid_ >> 3, vc = (tid_ & 7) * 8;
            v4u svv[4];
#pragma unroll
            for (int j = 0; j < 4; ++j) svv[j] = *(const v4u*)(F.XC + (size_t)(row0 + 64 * j + vr) * 4096 + g * 256 + hh * 64 + vc);
            {
                f32x4 t0[2][7], t1[2][7];
#define SSDB_LD(q, cp) do { const int ch_ = tid_ + (q) * (NWAVES * 64), p_ = ch_ >> 4, nc_ = ch_ & 15; const int cq_ = (cp) < c ? (cp) : 0; \
                    const float* sp_ = F.ST + ((size_t)((b * 8 + cq_) * SH + 4 * g + hh) * SP + p_) * SN + 8 * nc_; t0[q][cp] = *(const f32x4*)sp_; t1[q][cp] = *(const f32x4*)(sp_ + 4); } while (0)
#define SSDB_ACC(q) do { const int ch_ = tid_ + (q) * (NWAVES * 64), p_ = ch_ >> 4, nc_ = ch_ & 15; f32x4 a0 = {0.f, 0.f, 0.f, 0.f}, a1 = {0.f, 0.f, 0.f, 0.f}; \
                    _Pragma("unroll") for (int cp = 0; cp < 7; ++cp) { if (cp < c) { const float f_ = facL[cp * 4 + hh]; a0 += f_ * t0[q][cp]; a1 += f_ * t1[q][cp]; } } \
                    *(LAS v4u*)(PT + KSWZ(p_, nc_ * 16)) = (v4u){pk2(a0.x, a0.y), pk2(a0.z, a0.w), pk2(a1.x, a1.y), pk2(a1.z, a1.w)}; } while (0)
#pragma unroll
                for (int cp = 0; cp < 7; ++cp) SSDB_LD(0, cp);
#pragma unroll
                for (int cp = 0; cp < 5; ++cp) SSDB_LD(1, cp);
                SSDB_ACC(0);
                SSDB_LD(1, 5); SSDB_LD(1, 6);
                SSDB_ACC(1);
#undef SSDB_LD
#undef SSDB_ACC
            }
#pragma unroll
            for (int j = 0; j < 4; ++j) *(LAS v4u*)(VT + (j >> 1) * 16384 + att::v_st(vr, vc + 64 * (j & 1))) = scale8(svv[j], dtL[hh * 256 + 64 * j + vr]);
            __syncthreads();
            f32x16 o[2] = {};
            {   const LAS unsigned char* kb[4];
#pragma unroll
                for (int dd = 0; dd < 4; ++dd) kb[dd] = PT + KSWZ(r32, (dd * 16 + hi * 8) * 2);
#pragma unroll
                for (int d0 = 0; d0 < 8; ++d0) { const LAS unsigned char* a = kb[d0 & 3] + (d0 >> 2) * 128;
                    const bf16x8 b0 = *reinterpret_cast<const LAS bf16x8*>(a), b1 = *reinterpret_cast<const LAS bf16x8*>(a + 32 * 256);
                    o[0] = __builtin_amdgcn_mfma_f32_32x32x16_bf16(qr[d0], b0, o[0], 0, 0, 0);
                    o[1] = __builtin_amdgcn_mfma_f32_32x32x16_bf16(qr[d0], b1, o[1], 0, 0, 0); }
#pragma unroll
                for (int rr = 0; rr < 16; ++rr) { const float e = __expf(csL[hh * 256 + 32 * w + att::crow(rr, hi)]); o[0][rr] *= e; o[1][rr] *= e; }
            }
            const float cl = csL[hh * 256 + 32 * w + r32];
#pragma unroll 1
            for (int j = 0; j < 4; ++j) {
                if (64 * j <= 32 * w + 31) {
                    f32x16 p0, p1;
                    att::qkt(p0, p1, BK + j * 16384, r32, hi, qr);
                    const int vb0 = vb_base + (j >> 1) * 16384;
                    const int dl = 32 * w + r32 - 64 * j - 4 * hi;
                    const LAS float* csk = csL + hh * 256 + 64 * j + 4 * hi;
#pragma unroll
                    for (int rr = 0; rr < 16; ++rr) { const int cc = (rr & 3) + 8 * (rr >> 2);
                        const float e0 = __builtin_amdgcn_exp2f((cl - csk[cc]) * 1.4426950408889634f), e1 = __builtin_amdgcn_exp2f((cl - csk[cc + 32]) * 1.4426950408889634f);
                        p0[rr] = (dl - cc >= 0) ? p0[rr] * e0 : 0.f; p1[rr] = (dl - cc - 32 >= 0) ? p1[rr] * e1 : 0.f; }
                    bf16x8 pa0, pa1, pa2, pa3;
                    ATT_PK4(p0, 0, pa0); ATT_PK4(p0, 8, pa1); ATT_PK4(p1, 0, pa2); ATT_PK4(p1, 8, pa3);
                    if (j & 1) { ATT_PV_D0(o[0], 2, pa0, pa1, pa2, pa3); ATT_PV_D0(o[1], 3, pa0, pa1, pa2, pa3); }
                    else { ATT_PV_D0(o[0], 0, pa0, pa1, pa2, pa3); ATT_PV_D0(o[1], 1, pa0, pa1, pa2, pa3); }
                }
            }
            __syncthreads();
#pragma unroll
            for (int d0 = 0; d0 < 2; ++d0)
#pragma unroll
                for (int rr = 0; rr < 16; ++rr) ep[att::crow(rr, hi) * 64 + d0 * 32 + r32] = o[d0][rr];
            LDS_WAIT(); asm volatile("" ::: "memory");
            { const int chn = g * 256 + hh * 64 + 8 * (lane & 7); const float dsk = F.d_skip[4 * g + hh];
              v4u xw[4], zw[4];
#pragma unroll
              for (int it = 0; it < 4; ++it) { const size_t row = (size_t)row0 + 32 * w + 8 * it + (lane >> 3);
                  xw[it] = *(const v4u*)(F.XC + row * 4096 + chn); zw[it] = *(const v4u*)(F.PROJ + row * NPROJ + Z0 + chn); }
#pragma unroll
              for (int it = 0; it < 4; ++it) { const int rr = 8 * it + (lane >> 3); const size_t row = (size_t)row0 + 32 * w + rr;
                  const f32x4 o0 = *(const LAS f32x4*)(ep + rr * 64 + 8 * (lane & 7)), o1 = *(const LAS f32x4*)(ep + rr * 64 + 8 * (lane & 7) + 4);
                  const unsigned xq[4] = {xw[it].x, xw[it].y, xw[it].z, xw[it].w}, zq[4] = {zw[it].x, zw[it].y, zw[it].z, zw[it].w};
                  f32x4 y0, y1;
                  y0.x = (o0.x + dsk * bflo(xq[0])) * silu_f(bflo(zq[0])); y0.y = (o0.y + dsk * bfhi(xq[0])) * silu_f(bfhi(zq[0]));
                  y0.z = (o0.z + dsk * bflo(xq[1])) * silu_f(bflo(zq[1])); y0.w = (o0.w + dsk * bfhi(xq[1])) * silu_f(bfhi(zq[1]));
                  y1.x = (o1.x + dsk * bflo(xq[2])) * silu_f(bflo(zq[2])); y1.y = (o1.y + dsk * bfhi(xq[2])) * silu_f(bfhi(zq[2]));
                  y1.z = (o1.z + dsk * bflo(xq[3])) * silu_f(bflo(zq[3])); y1.w = (o1.w + dsk * bfhi(xq[3])) * silu_f(bfhi(zq[3]));
                  *(f32x4*)(F.YG + row * SW + chn) = y0; *(f32x4*)(F.YG + row * SW + chn + 4) = y1; } }
            __syncthreads();
        }
        asm volatile("s_waitcnt vmcnt(0)" ::: "memory");
        { const f32x4 nw = *(const f32x4*)(F.ssd_norm_w + g * 256 + 4 * lane);
#pragma unroll 1
          for (int r8 = 0; r8 < 32; r8 += 16) { f32x4 v[16];
#pragma unroll
              for (int q = 0; q < 16; ++q) v[q] = *(const f32x4*)(F.YG + ((size_t)row0 + 32 * w + r8 + q) * SW + g * 256 + 4 * lane);
#pragma unroll
              for (int q = 0; q < 16; ++q) { const size_t row = (size_t)row0 + 32 * w + r8 + q;
                  const float ss = wave_sum((v[q].x * v[q].x + v[q].y * v[q].y) + (v[q].z * v[q].z + v[q].w * v[q].w));
                  const float rstd = 1.0f / sqrtf(ss * (1.f / 256.f) + SSD_NORM_EPS);
                  *(v2u*)(F.MIX + row * D + AW + g * 256 + 4 * lane) = (v2u){pk2(v[q].x * rstd * nw.x, v[q].y * rstd * nw.y), pk2(v[q].z * rstd * nw.z, v[q].w * rstd * nw.w)}; } } }
        __syncthreads();
    }
}
__device__ __forceinline__ void p3_ssd_simple(const Frame& F0) {
    PIN_FRAME(F);
    for (int item = F.bx; item < NB * SH; item += F.G) {
        const int b = item / SH, h = item % SH, g = h / (SH / SG), p = F.tid >> 3, ns = F.tid & 7;
        float st[16];
#pragma unroll
        for (int i = 0; i < 16; ++i) st[i] = 0.f;
        const float dsk = F.d_skip[h];
        const size_t r0 = (size_t)b * SEQ;
        v4u B0 = *(const v4u*)(F.XC + r0 * 4096 + 2048 + g * SN + 16 * ns), B1 = *(const v4u*)(F.XC + r0 * 4096 + 2048 + g * SN + 16 * ns + 8);
        v4u C0 = *(const v4u*)(F.XC + r0 * 4096 + 3072 + g * SN + 16 * ns), C1 = *(const v4u*)(F.XC + r0 * 4096 + 3072 + g * SN + 16 * ns + 8);
        bf16 xv = F.XC[r0 * 4096 + h * SP + p]; float dtv = F.DT[r0 * SH + h], dav = F.DA[r0 * SH + h]; bf16 zv = F.PROJ[r0 * NPROJ + Z0 + h * SP + p];
#pragma unroll 1
        for (int t = 0; t < SEQ; ++t) {
            const size_t rn = r0 + (t + 1 < SEQ ? t + 1 : t);
            const v4u nB0 = *(const v4u*)(F.XC + rn * 4096 + 2048 + g * SN + 16 * ns), nB1 = *(const v4u*)(F.XC + rn * 4096 + 2048 + g * SN + 16 * ns + 8);
            const v4u nC0 = *(const v4u*)(F.XC + rn * 4096 + 3072 + g * SN + 16 * ns), nC1 = *(const v4u*)(F.XC + rn * 4096 + 3072 + g * SN + 16 * ns + 8);
            const bf16 nxv = F.XC[rn * 4096 + h * SP + p]; const float ndt = F.DT[rn * SH + h], nda = F.DA[rn * SH + h]; const bf16 nzv = F.PROJ[rn * NPROJ + Z0 + h * SP + p];
            const float xval = bf2f(xv), decay = __expf(dav), coef = dtv * xval;
            const unsigned bw[8] = {B0.x, B0.y, B0.z, B0.w, B1.x, B1.y, B1.z, B1.w}, cw[8] = {C0.x, C0.y, C0.z, C0.w, C1.x, C1.y, C1.z, C1.w};
            float y = 0.f;
#pragma unroll
            for (int i = 0; i < 8; ++i) {
                st[2 * i] = decay * st[2 * i] + coef * bflo(bw[i]); st[2 * i + 1] = decay * st[2 * i + 1] + coef * bfhi(bw[i]);
                y += bflo(cw[i]) * st[2 * i] + bfhi(cw[i]) * st[2 * i + 1];
            }
            y += __shfl_xor(y, 1); y += __shfl_xor(y, 2); y += __shfl_xor(y, 4);
            if (ns == 0) { const float z = bf2f(zv); F.YG[(r0 + t) * SW + h * SP + p] = (y + dsk * xval) * silu_f(z); }
            B0 = nB0; B1 = nB1; C0 = nC0; C1 = nC1; xv = nxv; dtv = ndt; dav = nda; zv = nzv;
        }
    }
}
__device__ __forceinline__ void p4_groupnorm(const Frame& F0) {
    PIN_FRAME(F);
    const int gw = F.bx * NWAVES + F.wave, NGW = F.G * NWAVES;
    for (int row = gw; row < T; row += NGW) {
        const f32x4* yp = (const f32x4*)(F.YG + (size_t)row * SW + 32 * F.lane); const f32x4* wp = (const f32x4*)(F.ssd_norm_w + 32 * F.lane);
        f32x4 v[8]; float s = 0.f;
#pragma unroll
        for (int j = 0; j < 8; ++j) { v[j] = yp[j]; s += (v[j].x * v[j].x + v[j].y * v[j].y) + (v[j].z * v[j].z + v[j].w * v[j].w); }
        s += __shfl_xor(s, 1); s += __shfl_xor(s, 2); s += __shfl_xor(s, 4);
        const float rstd = 1.0f / sqrtf(s * (1.f / 256.f) + SSD_NORM_EPS);
        v4u* op = (v4u*)(F.MIX + (size_t)row * D + AW + 32 * F.lane);
#pragma unroll
        for (int j = 0; j < 4; ++j) { const f32x4 a = v[2 * j], c = v[2 * j + 1], wa = wp[2 * j], wc = wp[2 * j + 1];
            op[j] = (v4u){pk2(a.x * rstd * wa.x, a.y * rstd * wa.y), pk2(a.z * rstd * wa.z, a.w * rstd * wa.w), pk2(c.x * rstd * wc.x, c.y * rstd * wc.y), pk2(c.z * rstd * wc.z, c.w * rstd * wc.w)}; }
    }
}

__device__ __forceinline__ void p6_router_simple(const Frame& F0) {
    PIN_FRAME(F);
    const int gw = F.bx * NWAVES + F.wave, NGW = F.G * NWAVES;
    LAS float* hn = (LAS float*)(F.lds + RING_OFF + F.wave * 16384);
    unsigned* cnt = F.ctl + CW_CNT;
    for (int tok = gw; tok < T; tok += NGW) {
        const f32x4* xr = (const f32x4*)(F.out + (size_t)tok * D) + F.lane; const f32x4* wr = (const f32x4*)F.norm_ffn_w + F.lane;
        f32x4 v[16]; float s = 0.f;
#pragma unroll
        for (int j = 0; j < 16; ++j) { v[j] = xr[64 * j]; s += (v[j].x * v[j].x + v[j].y * v[j].y) + (v[j].z * v[j].z + v[j].w * v[j].w); }
        const float rstd = 1.0f / sqrtf(wave_sum(s) * (1.f / D) + NORM_EPS);
        unsigned long long* o8 = (unsigned long long*)(F.Hb + (size_t)tok * D) + F.lane;
#pragma unroll
        for (int j = 0; j < 16; ++j) { const f32x4 w = wr[64 * j]; f32x4 y; y.x = v[j].x * rstd * w.x; y.y = v[j].y * rstd * w.y; y.z = v[j].z * rstd * w.z; y.w = v[j].w * rstd * w.w;
            o8[64 * j] = (unsigned long long)pk2(y.x, y.y) | ((unsigned long long)pk2(y.z, y.w) << 32);
            *(LAS f32x4*)(hn + 4 * (F.lane + 64 * j)) = y;
            if ((j & 3) == 3) asm volatile("" ::: "memory"); }
        LDS_WAIT(); asm volatile("" ::: "memory");
        f32x4 ga = {0.f, 0.f, 0.f, 0.f};
        { const f32x4* gp = (const f32x4*)F.rg_w + F.lane;
#pragma unroll 8
          for (int c = 0; c < D / 64; ++c) { const f32x4 w = gp[64 * c]; const float hv = hn[F.lane + 64 * c]; ga.x += hv * w.x; ga.y += hv * w.y; ga.z += hv * w.z; ga.w += hv * w.w; } }
        float gl[4];
        gl[0] = wave_sum(ga.x) + F.rg_b[0]; gl[1] = wave_sum(ga.y) + F.rg_b[1]; gl[2] = wave_sum(ga.z) + F.rg_b[2]; gl[3] = wave_sum(ga.w) + F.rg_b[3];
        f32x4 ea = {0.f, 0.f, 0.f, 0.f};
        const f32x4* ep = (const f32x4*)F.re_w + F.lane;
#pragma unroll 8
        for (int c = 0; c < D / 8; ++c) { const f32x4 w = ep[64 * c]; const float hv = hn[8 * c + (F.lane >> 3)]; ea.x += hv * w.x; ea.y += hv * w.y; ea.z += hv * w.z; ea.w += hv * w.w; }
#pragma unroll
        for (int o = 8; o < 64; o <<= 1) { ea.x += __shfl_xor(ea.x, o); ea.y += __shfl_xor(ea.y, o); ea.z += __shfl_xor(ea.z, o); ea.w += __shfl_xor(ea.w, o); }
        int gi = 0; float gm = gl[0];
#pragma unroll
        for (int c = 1; c < 4; ++c) if (gl[c] > gm) { gm = gl[c]; gi = c; }
        float gs = 0.f;
#pragma unroll
        for (int c = 0; c < 4; ++c) gs += __expf(gl[c] - gm);
        const float g_p = 1.0f / gs;
        float e8[8];
#pragma unroll
        for (int i = 0; i < 8; ++i) { const int src = 2 * gi + (i >> 2); const float v0 = __shfl(ea.x, src), v1 = __shfl(ea.y, src), v2 = __shfl(ea.z, src), v3 = __shfl(ea.w, src);
            const int q = i & 3; e8[i] = (q == 0 ? v0 : q == 1 ? v1 : q == 2 ? v2 : v3) + F.re_b[gi * EPG + i]; }
        int i1 = 0; float m1 = e8[0];
#pragma unroll
        for (int i = 1; i < 8; ++i) if (e8[i] > m1) { m1 = e8[i]; i1 = i; }
        int i2 = -1; float m2 = -__builtin_inff();
#pragma unroll
        for (int i = 0; i < 8; ++i) if (i != i1 && e8[i] > m2) { m2 = e8[i]; i2 = i; }
        const float p2 = __expf(m2 - m1), den = 1.0f + p2;
        const float gate1 = g_p / den, gate2 = g_p * p2 / den;
        if (F.lane == 0) {
            const int e1 = gi * EPG + i1, e2 = gi * EPG + i2;
            const unsigned s1 = xb_add(cnt + e1, 1u), s2 = xb_add(cnt + e2, 1u);
            F.tok_e[2 * tok] = e1; F.tok_e[2 * tok + 1] = e2; F.tok_slot[2 * tok] = (int)s1; F.tok_slot[2 * tok + 1] = (int)s2;
            F.tok_gate[2 * tok] = gate1; F.tok_gate[2 * tok + 1] = gate2;
        }
        LDS_WAIT(); asm volatile("" ::: "memory");
    }
}

__device__ __forceinline__ void p6_router_mfma(const Frame& F0) {
    PIN_FRAME(F);
    LAS float* red = (LAS float*)(F.lds + RING_OFF);
    LAS float* ssq = (LAS float*)(F.lds + RING_OFF + 49152);
    LAS float* lg = (LAS float*)(F.lds + RING_OFF + 50176);
    LAS float* rs = (LAS float*)(F.lds + RING_OFF + 56320);
    unsigned* cnt = F.ctl + CW_CNT;
    const int lane = F.lane, row = lane & 15, kq = lane >> 4;
#pragma unroll 1
    for (int item = F.bx; item < T / 16; item += 2 * F.G) {
        const bool has2 = item + F.G < T / 16;
        const int tokA = item * 16, tokB = (has2 ? item + F.G : item) * 16, kbase = F.wave * 512;
        const bf16* apA = F.X1B + (size_t)(tokA + row) * D + kbase + 8 * kq;
        const bf16* apB = F.X1B + (size_t)(tokB + row) * D + kbase + 8 * kq;
        const bf16x8* tb = (const bf16x8*)F.RW + (size_t)(kbase / 32) * 384 + lane;
        f32x4 a0 = {0.f, 0.f, 0.f, 0.f}, a1 = a0, a2 = a0, b0 = a0, b1 = a0, b2 = a0; float ssA = 0.f, ssB = 0.f;
#define P6_SS(w_) ((bflo(w_.x) * bflo(w_.x) + bfhi(w_.x) * bfhi(w_.x)) + (bflo(w_.y) * bflo(w_.y) + bfhi(w_.y) * bfhi(w_.y)) + (bflo(w_.z) * bflo(w_.z) + bfhi(w_.z) * bfhi(w_.z)) + (bflo(w_.w) * bflo(w_.w) + bfhi(w_.w) * bfhi(w_.w)))
#pragma unroll 4
        for (int j = 0; j < 16; ++j) {
            const v4u wA = *(const v4u*)(apA + 32 * j), wB = *(const v4u*)(apB + 32 * j); const bf16x8* t = tb + j * 384;
            const bf16x8 f0h = t[0], f0l = t[64], f1h = t[128], f1l = t[192], f2h = t[256], f2l = t[320];
            const bf16x8 xA = __builtin_bit_cast(bf16x8, wA), xB = __builtin_bit_cast(bf16x8, wB);
            ssA += P6_SS(wA); ssB += P6_SS(wB);
            a0 = __builtin_amdgcn_mfma_f32_16x16x32_bf16(xA, f0h, a0, 0, 0, 0); a1 = __builtin_amdgcn_mfma_f32_16x16x32_bf16(xA, f1h, a1, 0, 0, 0); a2 = __builtin_amdgcn_mfma_f32_16x16x32_bf16(xA, f2h, a2, 0, 0, 0);
            b0 = __builtin_amdgcn_mfma_f32_16x16x32_bf16(xB, f0h, b0, 0, 0, 0); b1 = __builtin_amdgcn_mfma_f32_16x16x32_bf16(xB, f1h, b1, 0, 0, 0); b2 = __builtin_amdgcn_mfma_f32_16x16x32_bf16(xB, f2h, b2, 0, 0, 0);
            a0 = __builtin_amdgcn_mfma_f32_16x16x32_bf16(xA, f0l, a0, 0, 0, 0); a1 = __builtin_amdgcn_mfma_f32_16x16x32_bf16(xA, f1l, a1, 0, 0, 0); a2 = __builtin_amdgcn_mfma_f32_16x16x32_bf16(xA, f2l, a2, 0, 0, 0);
            b0 = __builtin_amdgcn_mfma_f32_16x16x32_bf16(xB, f0l, b0, 0, 0, 0); b1 = __builtin_amdgcn_mfma_f32_16x16x32_bf16(xB, f1l, b1, 0, 0, 0); b2 = __builtin_amdgcn_mfma_f32_16x16x32_bf16(xB, f2l, b2, 0, 0, 0);
        }
#undef P6_SS
        ssA += __shfl_xor(ssA, 16); ssA += __shfl_xor(ssA, 32); ssB += __shfl_xor(ssB, 16); ssB += __shfl_xor(ssB, 32);
        { LAS float* rA = red + ((F.wave * 3) * 64 + lane) * 4; LAS float* rB = rA + 6144;
          *(LAS f32x4*)(rA) = a0; *(LAS f32x4*)(rA + 256) = a1; *(LAS f32x4*)(rA + 512) = a2;
          *(LAS f32x4*)(rB) = b0; *(LAS f32x4*)(rB + 256) = b1; *(LAS f32x4*)(rB + 512) = b2; }
        if (lane < 16) { ssq[F.wave * 16 + lane] = ssA; ssq[128 + F.wave * 16 + lane] = ssB; }
        __syncthreads();
        for (int t2 = F.tid; t2 < 1536; t2 += NWAVES * 64) { const int it = t2 >= 768 ? 1 : 0, t = t2 - 768 * it, tl = t >> 8, ln = (t >> 2) & 63, rg = t & 3; float v = 0.f;
#pragma unroll
            for (int w = 0; w < 8; ++w) v += red[it * 6144 + ((w * 3 + tl) * 64 + ln) * 4 + rg];
            lg[(16 * it + 4 * (ln >> 4) + rg) * 48 + tl * 16 + (ln & 15)] = v; }
        if (F.tid < 32) { float q = 0.f;
#pragma unroll
            for (int w = 0; w < 8; ++w) q += ssq[(F.tid >> 4) * 128 + w * 16 + (F.tid & 15)];
            rs[F.tid] = 1.0f / sqrtf(q * (1.f / D) + NORM_EPS); }
        __syncthreads();
        if (F.tid < 32 && (F.tid < 16 || has2)) {
            const int tok = (F.tid < 16 ? tokA : tokB) + (F.tid & 15); const float rstd = rs[F.tid]; const LAS float* l = lg + F.tid * 48;
            int gi = 0; float gm = l[0] * rstd + F.rg_b[0];
            float glv[4]; glv[0] = gm;
#pragma unroll
            for (int c = 1; c < 4; ++c) { glv[c] = l[c] * rstd + F.rg_b[c]; if (glv[c] > gm) { gm = glv[c]; gi = c; } }
            float gs = 0.f;
#pragma unroll
            for (int c = 0; c < 4; ++c) gs += __expf(glv[c] - gm);
            const float g_p = 1.0f / gs;
            int i1 = 0, i2 = -1; float m1 = -__builtin_inff(), m2 = -__builtin_inff();
            for (int i = 0; i < 8; ++i) { const float v = l[16 + gi * EPG + i] * rstd + F.re_b[gi * EPG + i];
                if (v > m1) { m2 = m1; i2 = i1; m1 = v; i1 = i; } else if (v > m2) { m2 = v; i2 = i; } }
            const float p2 = __expf(m2 - m1), den = 1.0f + p2;
            const int e1 = gi * EPG + i1, e2 = gi * EPG + i2;
            const unsigned s1 = xb_add(cnt + e1, 1u), s2 = xb_add(cnt + e2, 1u);
            F.row_tok[e1 * ECAP + (int)s1] = 2 * tok; F.row_tok[e2 * ECAP + (int)s2] = 2 * tok + 1;
            F.row_gate[e1 * ECAP + (int)s1] = g_p / den; F.row_gate[e2 * ECAP + (int)s2] = g_p * p2 / den;
        }
#pragma unroll 1
        for (int u = 0; u < 4; ++u) { const int tk = 4 * F.wave + u; if (tk >= 16 && !has2) break; const float rstd = rs[tk]; const size_t trow = (size_t)((tk < 16 ? tokA : tokB) + (tk & 15));
            const v4u* xr = (const v4u*)(F.X1B + trow * D) + lane; const f32x4* wr = (const f32x4*)F.norm_ffn_w + 2 * lane;
            v4u* o8 = (v4u*)(F.Hb + trow * D) + lane;
#pragma unroll
            for (int j = 0; j < 8; ++j) { const v4u v = xr[64 * j]; const f32x4 w0 = wr[128 * j], w1 = wr[128 * j + 1];
                o8[64 * j] = (v4u){pk2(bflo(v.x) * rstd * w0.x, bfhi(v.x) * rstd * w0.y), pk2(bflo(v.y) * rstd * w0.z, bfhi(v.y) * rstd * w0.w),
                                   pk2(bflo(v.z) * rstd * w1.x, bfhi(v.z) * rstd * w1.y), pk2(bflo(v.w) * rstd * w1.z, bfhi(v.w) * rstd * w1.w)}; } }
        __syncthreads();
    }
}
__device__ __forceinline__ void moe_tables(Frame& F) {
    LAS int* tile_e = (LAS int*)(F.lds + L_TILE_E); LAS int* pstart = (LAS int*)(F.lds + L_PSTART); LAS int* lcnt = (LAS int*)(F.lds + L_CNT);
    LAS int* xe = (LAS int*)(F.lds + L_XE);
    if (F.tid < NE) lcnt[F.tid] = (int)xb_ld(F.ctl + CW_CNT + F.tid);
    __syncthreads();
    if (F.tid < NE) {
        int pre = 0, tot = 0, mine = 0;
#pragma unroll
        for (int e2 = 0; e2 < NE; ++e2) { const int n2 = (lcnt[e2] + 255) >> 8; pre += e2 < F.tid ? n2 : 0; tot += n2; mine = e2 == F.tid ? n2 : mine; }
        pstart[F.tid] = pre * 256;
        for (int j = 0; j < mine; ++j) tile_e[pre + j] = F.tid;
        if (F.tid == 0) { pstart[NE] = tot * 256; pstart[NE + 1] = tot; } }
    if (F.tid >= 64 && F.tid < 64 + NE) {
        const int me = F.tid - 64, my = (lcnt[me] + 255) >> 8; int rank = 0;
        for (int e2 = 0; e2 < NE; ++e2) { const int o = (lcnt[e2] + 255) >> 8; rank += (o > my || (o == my && e2 < me)) ? 1 : 0; }
        const int row = rank >> 3, col = rank & 7; xe[((row & 1) ? 7 - col : col) * 4 + row] = me; }
    __syncthreads();
    if (F.tid < 64) {
        int tl = 0;
        if (F.tid < 8) {
#pragma unroll
            for (int q = 0; q < 4; ++q) tl += (lcnt[xe[F.tid * 4 + q]] + 255) >> 8; }
#pragma unroll
        for (int o = 1; o < 8; o <<= 1) { const int other = __shfl_xor(tl, o); tl = other > tl ? other : tl; }
        if (F.tid == 0) pstart[NE + 2] = ((F.G % 8) != 0 || tl * 8 > 8 * (F.G / 8)) ? 1 : 0; }
    __syncthreads();
}
__device__ __forceinline__ void p7_gather(const Frame& F0) {
    PIN_FRAME(F);
    moe_tables(F);
    const LAS int* pstart = (const LAS int*)(F.lds + L_PSTART); const LAS int* lcnt = (const LAS int*)(F.lds + L_CNT);
    for (int a = F.bx * 512 + F.tid; a < 2 * T; a += F.G * 512) { const int dest = pstart[F.tok_e[a]] + F.tok_slot[a]; F.row_tok[dest] = a; F.row_gate[dest] = F.tok_gate[a]; }
    if (F.bx < NE) { const int e = F.bx, hi = pstart[e + 1] - pstart[e];
        for (int r = lcnt[e] + F.tid; r < hi; r += NWAVES * 64) { F.row_tok[pstart[e] + r] = -1; F.row_gate[pstart[e] + r] = 0.f; } }
}
__device__ __forceinline__ void p10_combine(const Frame& F0) {
    PIN_FRAME(F);
    const size_t n8 = (size_t)T * D / 8;
#pragma unroll 2
    for (size_t i = (size_t)F.bx * 512 + F.tid; i < n8; i += (size_t)F.G * 512) {
        const v4u x = ((const v4u*)F.X1B)[i], y0 = ((const v4u*)F.YS)[i], y1 = ((const v4u*)(F.YS + (size_t)T * D))[i];
        f32x4 a, b;
        a.x = bflo(x.x) + bflo(y0.x) + bflo(y1.x); a.y = bfhi(x.x) + bfhi(y0.x) + bfhi(y1.x); a.z = bflo(x.y) + bflo(y0.y) + bflo(y1.y); a.w = bfhi(x.y) + bfhi(y0.y) + bfhi(y1.y);
        b.x = bflo(x.z) + bflo(y0.z) + bflo(y1.z); b.y = bfhi(x.z) + bfhi(y0.z) + bfhi(y1.z); b.z = bflo(x.w) + bflo(y0.w) + bflo(y1.w); b.w = bfhi(x.w) + bfhi(y0.w) + bfhi(y1.w);
        ((f32x4*)F.out)[2 * i] = a; ((f32x4*)F.out)[2 * i + 1] = b;
    }
}

constexpr int NPHASE = 11;
__global__ void __launch_bounds__(NWAVES * 64, 2) hymba_fwd(Args args) {
    extern __shared__ __attribute__((aligned(16))) unsigned char lds_raw[];
    Frame F;
    F.lds = (LAS unsigned char*)lds_raw;
    F.tid = threadIdx.x; F.lane = F.tid & 63; F.wave = __builtin_amdgcn_readfirstlane(F.tid >> 6);
    F.G = gridDim.x; F.bx = blockIdx.x;
    unsigned char* ws = args.ws;
    F.ctl = (unsigned*)(ws + WS_CTL);
    F.x = (const float*)args.in[0]; F.pos = (const int*)args.in[1]; F.norm_attn_w = (const float*)args.in[2]; F.w_in = (const float*)args.in[3];
    F.q_norm_w = (const float*)args.in[4]; F.k_norm_w = (const float*)args.in[5]; F.conv_w = (const float*)args.in[6]; F.conv_b = (const float*)args.in[7];
    F.dt_bias = (const float*)args.in[8]; F.a_log = (const float*)args.in[9]; F.d_skip = (const float*)args.in[10]; F.ssd_norm_w = (const float*)args.in[11];
    F.w_out = (const float*)args.in[12]; F.norm_ffn_w = (const float*)args.in[13]; F.rg_w = (const float*)args.in[14]; F.rg_b = (const float*)args.in[15];
    F.re_w = (const float*)args.in[16]; F.re_b = (const float*)args.in[17]; F.w_gate = (const float*)args.in[18]; F.w_up = (const float*)args.in[19]; F.w_down = (const float*)args.in[20];
    F.out = args.out;
    F.WinT = (bf16*)(ws + WS_WIN); F.WoT = (bf16*)(ws + WS_WOUT); F.WguT = (bf16*)(ws + WS_WGU); F.WdT = (bf16*)(ws + WS_WD);
    F.Hb = (bf16*)(ws + WS_H); F.PROJ = (bf16*)(ws + WS_PROJ); F.XG = (bf16*)(ws + WS_PROJ); F.QN = (bf16*)(ws + WS_QN); F.KN = (bf16*)(ws + WS_KN); F.XC = (bf16*)(ws + WS_XC);
    F.DT = (float*)(ws + WS_DT); F.DA = (float*)(ws + WS_DA); F.YG = (float*)(ws + WS_YG); F.MIX = (bf16*)(ws + WS_MIX); F.ACT = (bf16*)(ws + WS_ACT); F.YS = (bf16*)(ws + WS_YS);
    F.OBR = (bf16*)(ws + WS_OBR); F.ML = (float*)(ws + WS_ML); F.ST = (float*)(ws + WS_ST); F.CT = (float*)(ws + WS_CT); F.RW = (float*)(ws + WS_RW); F.X1B = (bf16*)(ws + WS_PROJ);
    F.tok_e = (int*)(ws + WS_TOK); F.tok_slot = F.tok_e + 2 * T; F.tok_gate = (float*)(F.tok_slot + 2 * T);
    F.row_tok = (int*)(ws + WS_WGU); F.row_gate = (float*)(F.row_tok + NE * ECAP);
    for (int u = F.tid; u < (LDS_BYTES - LDSCTL_OFF) / 4; u += NWAVES * 64) ((LAS unsigned*)(F.lds + LDSCTL_OFF))[u] = 0u;
    __syncthreads();
    XcdBarrier bar; bar.bar = F.ctl + CW_BAR; bar.x = 0; bar.st = nullptr;
#if MK_ONE_LAUNCH
    bar = xcd_barrier_post(F.ctl + CW_BAR, (volatile LAS unsigned*)(F.lds + L_MISC) + 8);
#define GRID_BAR() xcd_barrier(bar)
#else
#define GRID_BAR() do { } while (0)
#endif
    const int lo = args.ph_lo, hi = args.ph_hi;
#ifndef PHMASK
#define PHMASK 0xFFFF
#endif
#define IN(k) (((PHMASK >> (k)) & 1) && lo <= (k) && (k) < hi)
#define SEAM(k) do { if (IN(k) && IN((k) + 1)) GRID_BAR(); } while (0)

    if (IN(0)) { convert_weights<0>(F); convert_weights<1>(F); p0_prologue(F); } SEAM(0);
    if (IN(1)) {
        pg8::Gemm g{F.Hb, F.WinT, D}; pg8::StaticOrder S; S.init(T, NPROJ, F.G, F.bx);
        pg8::EpiBf16 E{F.PROJ, NPROJ};
        pg8::gemm_phase<pg8::EpiBf16, pg8::StaticOrder>(F.lds + RING_OFF, g, S, E);
        __syncthreads();
        p1_dt(F);
    } SEAM(1);
    if (IN(2)) { p2_prep(F); } SEAM(2);
#if defined(ATT_SIMPLE)
    if (IN(3)) { p3_ssd_simple(F); p3_attention_simple(F); } SEAM(3);
    if (IN(4)) { p4_groupnorm(F); } SEAM(4);
#else
#if defined(SSD_SIMPLE)
    if (IN(3)) { p3_ssd_simple(F); p3_attention_mfma(F); } SEAM(3);
    if (IN(4)) { p4_groupnorm(F); p4_attn_combine(F); } SEAM(4);
#else
    if (IN(3)) { p3_ssd_states(F); __syncthreads(); p3_attention_mfma(F); } SEAM(3);
    if (IN(4)) { p4_ssd_out(F); p4_attn_combine(F); } SEAM(4);
#endif
#endif
    if (IN(5)) {
        pg8::Gemm g{F.MIX, F.WoT, D}; pg8::StaticOrder S; S.init(T, D, F.G, F.bx);
        pg8::EpiResidBf16 E{F.x, F.X1B, D};
        pg8::gemm_phase<pg8::EpiResidBf16, pg8::StaticOrder>(F.lds + RING_OFF, g, S, E);
    } SEAM(5);
#if defined(ROUTER_SIMPLE)
    if (IN(6)) { p6_router_simple(F); } SEAM(6);
#else
    if (IN(6)) { p6_router_mfma(F); } SEAM(6);
#endif
    if (IN(8)) {
        moe_tables(F);
        const int MT = ((const LAS int*)(F.lds + L_PSTART))[NE + 1];
        pg2::Moe2Order S{MT, FF / 128, F.G, F.bx, (const LAS int*)(F.lds + L_PSTART), ((const LAS int*)(F.lds + L_PSTART))[NE + 2], (const LAS int*)(F.lds + L_XE)};
        LAS unsigned* rowoff = (LAS unsigned*)(F.lds + L_SSD);
        {
            const LAS int* ps_ = (const LAS int*)(F.lds + L_PSTART); const LAS int* lc_ = (const LAS int*)(F.lds + L_CNT);
            const int hf_ = F.tid >> 8, rw_ = F.tid & 255;
            for (int i0_ = 0; i0_ < 8; i0_ += 4) {
                pg2::Unit2 ua, ub; const bool oka = S.next(i0_ + hf_, ua), okb = S.next(i0_ + 2 + hf_, ub);
                int rta = -1, rtb = -1;
                if (oka) { const int s_ = (ua.pm - (ps_[ua.e] >> 8)) * 256 + rw_; if (s_ < lc_[ua.e]) rta = F.row_tok[ua.e * ECAP + s_]; }
                if (okb) { const int s_ = (ub.pm - (ps_[ub.e] >> 8)) * 256 + rw_; if (s_ < lc_[ub.e]) rtb = F.row_tok[ub.e * ECAP + s_]; }
                if (oka) rowoff[(i0_ + hf_) * 256 + rw_] = (unsigned)(rta >= 0 ? rta >> 1 : 0) * (unsigned)(D * 2);
                if (okb) rowoff[(i0_ + 2 + hf_) * 256 + rw_] = (unsigned)(rtb >= 0 ? rtb >> 1 : 0) * (unsigned)(D * 2);
                if (!okb) break; } }
        __syncthreads();
        pg3::EpiGateUp3 E{F.ACT, FF, F.ctl + CW_TILE};
        pg3::gemm3_phase<pg3::EpiGateUp3, pg2::Moe2Order, pg3::GateUpB, true>(F.lds + RING_OFF, F.Hb, D, S, pg3::GateUpB{F.w_gate, F.w_up}, E, (const LAS unsigned*)rowoff);
        __syncthreads();
        {
        const int flat2 = ((const LAS int*)(F.lds + L_PSTART))[NE + 2];
#ifdef DOWN_PG2
        pg2::Moe2OrderQ S2{MT, D / 128, F.bx, (const LAS int*)(F.lds + L_PSTART), flat2, (const LAS int*)(F.lds + L_XE), F.ctl + CW_TILE, F.ctl + 2, F.ctl + CW_DQ + 16 * (flat2 ? 0 : (F.bx & 7)), (LAS int*)(F.lds + L_XE + 128)};
        pg2::EpiDown2 E2{F.YS, D, T, F.row_tok, F.row_gate};
        pg2::gemm2_phase<pg2::EpiDown2, pg2::Moe2OrderQ, pg2::DownB, false>(F.lds + RING_OFF, F.ACT, FF, S2, pg2::DownB{F.w_down}, E2, nullptr);
#else
        pg2::Moe2OrderQ S2{MT, D / 256, F.bx, (const LAS int*)(F.lds + L_PSTART), flat2, (const LAS int*)(F.lds + L_XE), F.ctl + CW_TILE, F.ctl + 2, F.ctl + CW_DQ + 16 * (flat2 ? 0 : (F.bx & 7)), (LAS int*)(F.lds + L_XE + 128)};
        pg3::EpiDown3 E2{F.YS, D, T, F.row_tok, F.row_gate, (const LAS int*)(F.lds + L_PSTART), (const LAS int*)(F.lds + L_CNT)};
        pg3::gemm3_phase<pg3::EpiDown3, pg2::Moe2OrderQ, pg3::DownB3, false>(F.lds + RING_OFF, F.ACT, FF, S2, pg3::DownB3{F.w_down}, E2, nullptr);
#endif
        }
    } SEAM(9);
    if (IN(10)) { p10_combine(F); }
#undef IN
#undef SEAM
}

extern "C" void kernel_launch(void* const* d_in, const int* in_sizes, int n_in, void* d_out, int out_size, void* d_ws, size_t ws_size, hipStream_t stream) {
    static int grid = 0;
    if (grid == 0) {
        if (n_in != 21 || out_size != T * D || ws_size < WS_END) { fprintf(stderr, "kernel_launch: unexpected shapes (n_in %d out %d ws %zu, need %zu)\n", n_in, out_size, ws_size, (size_t)WS_END); grid = -1; return; }
        int dev = 0, cus = 0, per_cu = 0;
        if (hipGetDevice(&dev) != hipSuccess || hipDeviceGetAttribute(&cus, hipDeviceAttributeMultiprocessorCount, dev) != hipSuccess) { grid = -1; return; }
        if (hipFuncSetAttribute((const void*)hymba_fwd, hipFuncAttributeMaxDynamicSharedMemorySize, LDS_BYTES) != hipSuccess) { fprintf(stderr, "kernel_launch: hipFuncSetAttribute failed\n"); grid = -1; return; }
        if (hipOccupancyMaxActiveBlocksPerMultiprocessor(&per_cu, (const void*)hymba_fwd, NWAVES * 64, LDS_BYTES) != hipSuccess || per_cu < 1) { fprintf(stderr, "kernel_launch: occupancy query says %d\n", per_cu); (void)hipGetLastError(); }
        grid = cus;
    }
    if (grid < 0) return;
    (void)hipMemsetAsync((char*)d_ws + WS_CTL, 0, CTL_ZERO_BYTES, stream);
    Args a{};
    for (int i = 0; i < 21; ++i) a.in[i] = d_in[i];
    a.out = (float*)d_out; a.ws = (unsigned char*)d_ws;
#if MK_ONE_LAUNCH
    a.ph_lo = 0; a.ph_hi = NPHASE;
    hipLaunchKernelGGL(hymba_fwd, dim3(grid), dim3(NWAVES * 64), LDS_BYTES, stream, a);
#else
    for (int p = 0; p < NPHASE; ++p) { a.ph_lo = p; a.ph_hi = p + 1; hipLaunchKernelGGL(hymba_fwd, dim3(grid), dim3(NWAVES * 64), LDS_BYTES, stream, a); }
#endif
}
```
